# Optimizing an MI355X kernel written in HIP

```python
import jax, jax.numpy as jnp
from jax import lax
import numpy as np

D_MODEL = 2048
BATCH = 4
SEQ = 2048
DEPTH = 1

MIX_W = D_MODEL
POOL_W = MIX_W // 2
POOL_WINDOWS = (2, 4, 8, 16)
POOL_GROUPS = len(POOL_WINDOWS)
POOL_CH = POOL_W // POOL_GROUPS
ATTN_W = MIX_W - POOL_W
HEAD_DIM = 128
N_HEADS = ATTN_W // HEAD_DIM
KV_HEADS = 2
Q_PER_KV = N_HEADS // KV_HEADS
KV_W = KV_HEADS * HEAD_DIM
IDX_HEADS = 16
IDX_DIM = 128
INDEX_TOPK = 256
Q_BLOCK = 128
D_FF = 4 * D_MODEL
RMS_EPS = 1e-6
IN_SIZES = (POOL_W, ATTN_W, KV_W, KV_W, IDX_HEADS * IDX_DIM, IDX_DIM, IDX_HEADS)
IN_W = sum(IN_SIZES)
IN_SPLITS = tuple(int(v) for v in np.cumsum(IN_SIZES)[:-1])

kernel_name = "hymba_pool_dsa_hybrid_layer"


def rms_norm(x, g):
    xf = x.astype(jnp.float32)
    y = xf * lax.rsqrt(jnp.mean(xf * xf, axis=-1, keepdims=True) + RMS_EPS)
    return (y * g.astype(jnp.float32)).astype(x.dtype)


def modulate(h, shift, scale):
    return h * (1 + scale[:, None, :]) + shift[:, None, :]


def multiscale_pool_mixer(u, w_pool, pool_scale):
    B, S, _ = u.shape
    ug = u.reshape(B, S, POOL_GROUPS, POOL_CH)
    cs = jnp.cumsum(ug.astype(jnp.float32), axis=1)
    cs = jnp.pad(cs, ((0, 0), (1, 0), (0, 0), (0, 0)))
    t = jnp.arange(S)
    outs = []
    for gi, win in enumerate(POOL_WINDOWS):
        lo = jnp.maximum(t + 1 - win, 0)
        total = cs[:, 1:, gi] - cs[:, lo, gi]
        count = jnp.minimum(t + 1, win).astype(jnp.float32)
        outs.append(total / count[None, :, None] - ug[:, :, gi].astype(jnp.float32))
    pooled = jnp.stack(outs, axis=2).astype(u.dtype)
    mixed = jnp.einsum('bsgc,gcd->bsgd', pooled, w_pool)
    return mixed.reshape(B, S, POOL_W) * pool_scale


def dsa_sparse_attention(q, k, v, q_idx, k_idx, w_idx):
    B, S = q.shape[0], q.shape[1]
    topk = min(INDEX_TOPK, S // 4)
    nb = S // Q_BLOCK
    idx_scale = (IDX_HEADS ** -0.5) * (IDX_DIM ** -0.5)
    key_pos = jnp.arange(S)
    gather = jax.vmap(lambda a, i: a[i])

    def to_blocks(a):
        return a.reshape((B, nb, Q_BLOCK) + a.shape[2:]).swapaxes(0, 1)

    def one_block(args):
        qb, qib, wb, t0 = args
        tpos = t0 + jnp.arange(Q_BLOCK)
        rel = jax.nn.relu(jnp.einsum('bthd,bsd->bths', qib, k_idx).astype(jnp.float32))
        score = jnp.einsum('bth,bths->bts', wb.astype(jnp.float32), rel) * idx_scale
        causal = key_pos[None, :] <= tpos[:, None]
        score = jnp.where(causal[None], score, -jnp.inf)
        _, sel = lax.top_k(score, topk)
        k_sel = gather(k, sel)
        v_sel = gather(v, sel)
        qg = qb.reshape(B, Q_BLOCK, KV_HEADS, Q_PER_KV, HEAD_DIM)
        logits = jnp.einsum('btgrd,btkgd->btgrk', qg, k_sel).astype(jnp.float32) * (HEAD_DIM ** -0.5)
        valid = (sel <= tpos[None, :, None])[:, :, None, None, :]
        logits = jnp.where(valid, logits, -jnp.inf)
        p = jax.nn.softmax(logits, axis=-1).astype(v.dtype)
        o = jnp.einsum('btgrk,btkgd->btgrd', p, v_sel)
        return o.reshape(B, Q_BLOCK, ATTN_W)

    starts = jnp.arange(nb) * Q_BLOCK
    out = lax.map(one_block, (to_blocks(q), to_blocks(q_idx), to_blocks(w_idx), starts))
    return out.swapaxes(0, 1).reshape(B, S, ATTN_W)


def setup_inputs(seed: int = 0) -> dict:
    key = jax.random.key(seed)
    ks = jax.random.split(key, 20)
    f32 = jnp.float32
    D = D_MODEL

    def nrm(k, shape, scale):
        return jax.random.normal(k, shape, f32) * scale

    def gain(k, shape):
        return 1.0 + 0.02 * jax.random.normal(k, shape, f32)

    return {
        "x": jax.random.normal(ks[0], (BATCH, SEQ, D), f32),
        "c": jax.random.normal(ks[1], (BATCH, D), f32),
        "w_ada": nrm(ks[2], (DEPTH, D, 6 * D), D ** -0.5),
        "b_ada": nrm(ks[3], (DEPTH, 6 * D), 0.01),
        "g_pre_mix": gain(ks[4], (DEPTH, D)),
        "g_post_mix": gain(ks[5], (DEPTH, D)),
        "g_pre_ffn": gain(ks[6], (DEPTH, D)),
        "g_post_ffn": gain(ks[7], (DEPTH, D)),
        "w_in": nrm(ks[8], (DEPTH, D, IN_W), D ** -0.5),
        "w_pool": nrm(ks[9], (DEPTH, POOL_GROUPS, POOL_CH, POOL_CH), POOL_CH ** -0.5),
        "pool_scale": gain(ks[10], (DEPTH, POOL_W)),
        "g_pool_out": gain(ks[11], (DEPTH, POOL_W)),
        "g_attn_out": gain(ks[12], (DEPTH, ATTN_W)),
        "w_out": nrm(ks[13], (DEPTH, MIX_W, D), MIX_W ** -0.5),
        "w_ff1": nrm(ks[14], (DEPTH, D, D_FF), D ** -0.5),
        "w_ff2": nrm(ks[15], (DEPTH, D_FF, D), D_FF ** -0.5),
    }


def reference(x, c, w_ada, b_ada, g_pre_mix, g_post_mix, g_pre_ffn, g_post_ffn,
              w_in, w_pool, pool_scale, g_pool_out, g_attn_out, w_out, w_ff1, w_ff2):
    B, S, D = x.shape
    c_act = jax.nn.silu(c)
    for l in range(DEPTH):
        mod = jnp.einsum('bd,de->be', c_act, w_ada[l]) + b_ada[l]
        shift1, scale1, gate1, shift2, scale2, gate2 = jnp.split(mod, 6, axis=-1)

        h = modulate(rms_norm(x, g_pre_mix[l]), shift1, scale1)
        z = jnp.einsum('bsd,de->bse', h, w_in[l])
        z_pool, z_q, z_k, z_v, z_iq, z_ik, z_iw = jnp.split(z, IN_SPLITS, axis=-1)
        pool_out = multiscale_pool_mixer(z_pool, w_pool[l], pool_scale[l])
        attn_out = dsa_sparse_attention(
            z_q.reshape(B, S, N_HEADS, HEAD_DIM),
            z_k.reshape(B, S, KV_HEADS, HEAD_DIM),
            z_v.reshape(B, S, KV_HEADS, HEAD_DIM),
            z_iq.reshape(B, S, IDX_HEADS, IDX_DIM),
            z_ik, z_iw)
        merged = jnp.concatenate(
            [rms_norm(pool_out, g_pool_out[l]), rms_norm(attn_out, g_attn_out[l])], axis=-1)
        mix = jnp.einsum('bse,ed->bsd', merged, w_out[l])
        x = x + gate1[:, None, :] * rms_norm(mix, g_post_mix[l])

        h2 = modulate(rms_norm(x, g_pre_ffn[l]), shift2, scale2)
        f = jnp.square(jax.nn.relu(jnp.einsum('bsd,df->bsf', h2, w_ff1[l])))
        f = jnp.einsum('bsf,fd->bsd', f, w_ff2[l])
        x = x + gate2[:, None, :] * rms_norm(f, g_post_ffn[l])
    return x
```

```cpp
#include <hip/hip_runtime.h>
#include <hip/hip_cooperative_groups.h>
#include <cstdio>
#include <cstdint>
namespace cg = cooperative_groups;

#ifndef MK_N_LAUNCHES
#define MK_N_LAUNCHES 1
#endif

#define LAS __attribute__((address_space(3)))
#define GAS __attribute__((address_space(1)))
typedef _Float16 f16;
typedef _Float16 h16x8 __attribute__((ext_vector_type(8)));
typedef _Float16 h16x2 __attribute__((ext_vector_type(2)));
typedef short s16x4 __attribute__((ext_vector_type(4)));
typedef float f32x2 __attribute__((ext_vector_type(2)));
typedef float f32x4 __attribute__((ext_vector_type(4)));
typedef float f32x16 __attribute__((ext_vector_type(16)));
typedef unsigned u32x2 __attribute__((ext_vector_type(2)));
typedef unsigned u32x4 __attribute__((ext_vector_type(4)));

constexpr int NB = 4, SEQ = 2048, T = NB * SEQ, DM = 2048, FF = 8192;
constexpr int INW = 4752, INWP = 4864;
constexpr int TOPK = 256;
constexpr float RMS_EPS = 1e-6f;
constexpr int NWAVES = 8, NTHREADS = 512;

constexpr size_t MiB = 1u << 20;
constexpr size_t WS_CTL = 0, CTL_ZERO_BYTES = 1 * MiB;
constexpr size_t CTL_MODACC = 256 * 1024;
constexpr size_t WS_WIN = 1 * MiB, WS_WOUT = 20 * MiB, WS_WFF1 = 28 * MiB, WS_WFF2 = 60 * MiB, WS_WPOOL = 92 * MiB;
constexpr size_t WS_PART = 93 * MiB;
constexpr size_t WS_IDXW = 97 * MiB;
constexpr size_t WS_MASK = 98 * MiB;
constexpr size_t WS_H = 100 * MiB;
constexpr size_t WS_F2 = 100 * MiB;
constexpr size_t WS_ZP = 164 * MiB, WS_POOLED = 180 * MiB, WS_Q = 196 * MiB, WS_K = 212 * MiB, WS_V = 216 * MiB, WS_IDXK = 220 * MiB, WS_IDXQ = 222 * MiB;
constexpr size_t WS_MRAW = 254 * MiB;
constexpr size_t WS_SCORES = 286 * MiB;
constexpr size_t WS_MIX = 286 * MiB;
constexpr size_t WS_F1 = 164 * MiB;
constexpr size_t WS_END = 350 * MiB;
constexpr int CW_TMO = 0, CW_BAR = 4096;

constexpr int RING_BYTES = 131072;
constexpr int LDS_BYTES = 147456;
constexpr int MISC_OFF = LDS_BYTES - 512;

#define LDS_WAIT() asm volatile("s_waitcnt lgkmcnt(0)" ::: "memory")
#define VM_WAIT() asm volatile("s_waitcnt vmcnt(0)" ::: "memory")
__device__ __forceinline__ unsigned pkh(float lo, float hi) { f32x2 v = {lo, hi}; h16x2 h = __builtin_convertvector(v, h16x2); return __builtin_bit_cast(unsigned, h); }
__device__ __forceinline__ int wave_sum_i(int v) {
    v += __builtin_amdgcn_update_dpp(0, v, 0xB1, 0xf, 0xf, true);
    v += __builtin_amdgcn_update_dpp(0, v, 0x4E, 0xf, 0xf, true);
    v += __builtin_amdgcn_update_dpp(0, v, 0x141, 0xf, 0xf, true);
    v += __builtin_amdgcn_update_dpp(0, v, 0x140, 0xf, 0xf, true);
    return __builtin_amdgcn_readlane(v, 0) + __builtin_amdgcn_readlane(v, 16) + __builtin_amdgcn_readlane(v, 32) + __builtin_amdgcn_readlane(v, 48);
}
__device__ __forceinline__ float wave_sum(float v) {
#pragma unroll
    for (int o = 1; o < 64; o <<= 1) v += __shfl_xor(v, o);
    return v;
}

namespace pg8 {
constexpr int BM = 256, BK = 64, HALF = 128, HTB = HALF * BK * 2, STAGE_BYTES = 8 * HTB, NXCD = 8, WGM = 8;
__host__ __device__ __forceinline__ int lds_byte(int r, int c) { const int st = (r >> 4) * 2 + (c >> 5), rr = r & 15, cc = c & 31, ob = rr * 64 + cc * 2; return st * 1024 + (ob ^ (((ob >> 9) & 1) << 5)); }
__host__ __device__ __forceinline__ void stage_rc(int b, int& R, int& C) { const int st = b / 1024, sb = b % 1024, swz = sb ^ (((sb >> 9) & 1) << 5); R = (st >> 1) * 16 + swz / 64; C = (st & 1) * 32 + (swz % 64) / 2; }
__host__ __device__ __forceinline__ int perm32(int rho) { const int n = rho >> 4, i = rho & 15; return 8 * (i >> 2) + 4 * n + (i & 3); }

struct Unit { int pm, pn; };
struct Gemm { const f16* A; const f16* Bt; int lda, ldb, K, a_pn_bytes; };

struct StaticOrder {
    int nM, nN, nwg, G, c;
    __device__ void init(int M, int N, int G_, int c_) { nM = M / BM; nN = N / BM; nwg = nM * nN; G = G_; c = c_; }
    __device__ bool next(int i, Unit& u) const {
        const long L = (long)i * G + c; if (L >= nwg) return false;
        int wgid = (int)L; { const int q = nwg / NXCD, r = nwg % NXCD, xcd = wgid % NXCD, off = wgid / NXCD; wgid = (xcd < r ? xcd * (q + 1) : r * (q + 1) + (xcd - r) * q) + off; }
        const int nig = WGM * nN, gid = wgid / nig, fm = gid * WGM, gsz = (nM - fm) < WGM ? (nM - fm) : WGM;
        u.pm = fm + ((wgid % nig) % gsz); u.pn = (wgid % nig) / gsz; return true;
    }
};

template <class Epi, bool ALIGN_EPI>
__device__ __forceinline__ void gemm_phase(LAS unsigned char* lds, const Gemm g, const StaticOrder& S, const Epi& E) {
    const int tid = threadIdx.x, wid = __builtin_amdgcn_readfirstlane(tid >> 6), lane = tid & 63, wr = wid >> 2, wc = wid & 3, fr = lane & 15, fq = lane >> 4;
    const int K = g.K, nt = K / BK;
    unsigned voffA[2], voffB[2];
#pragma unroll
    for (int i = 0; i < 2; ++i) { int R, C; stage_rc(tid * 16 + i * 8192, R, C); const int Rb = Epi::PERM ? ((R & ~31) + perm32(R & 31)) : R;
        voffA[i] = (unsigned)(R * g.lda + C) * 2u; voffB[i] = (unsigned)(Rb * g.ldb + C) * 2u; }
    const size_t kstep = (size_t)(BK * 2);
    const size_t hstepA = (size_t)HALF * g.lda * 2, hstepB = (size_t)HALF * g.ldb * 2;
    const size_t tstepA = 2 * hstepA, tstepB = 2 * hstepB;
    const unsigned ldsw = (unsigned)wid * 1024u;
    const int aoff = lds_byte(wr * 64 + fr, fq * 8), boff = lds_byte(wc * 32 + fr, fq * 8);
#define PG8_SA(b, h) (((b) * 2 + (h)) * HTB)
#define PG8_SB(b, h) ((4 + (b) * 2 + (h)) * HTB)
#define PG8_STAGE(bufoff, gbase, voff) do { _Pragma("unroll") for (int _i = 0; _i < 2; ++_i) \
        __builtin_amdgcn_global_load_lds((const unsigned*)((const char*)(gbase) + (voff)[_i]), (LAS unsigned*)(lds + (bufoff) + ldsw + _i * 8192), 16, 0, 0); } while (0)
#define PG8_LDA(dst, b, h) do { _Pragma("unroll") for (int m = 0; m < 4; ++m) _Pragma("unroll") for (int k = 0; k < 2; ++k) dst[m][k] = *(const LAS h16x8*)(lds + PG8_SA(b, h) + aoff + m * 2048 + k * 1024); } while (0)
#define PG8_LDB(dst, b, h) do { _Pragma("unroll") for (int n = 0; n < 2; ++n) _Pragma("unroll") for (int k = 0; k < 2; ++k) dst[n][k] = *(const LAS h16x8*)(lds + PG8_SB(b, h) + boff + n * 2048 + k * 1024); } while (0)
#define PG8_MMA(ai, bj, At, Bt) do { __builtin_amdgcn_s_setprio(1); _Pragma("unroll") for (int m = 0; m < 4; ++m) _Pragma("unroll") for (int n = 0; n < 2; ++n) _Pragma("unroll") for (int k = 0; k < 2; ++k) \
        acc[ai][bj][m][n] = __builtin_amdgcn_mfma_f32_16x16x32_f16(Bt[n][k], At[m][k], acc[ai][bj][m][n], 0, 0, 0); __builtin_amdgcn_s_setprio(0); } while (0)
#define PG8_WAIT_V(n) asm volatile("s_waitcnt vmcnt(" #n ")" ::: "memory")
#define PG8_WAIT_L(n) asm volatile("s_waitcnt lgkmcnt(" #n ")" ::: "memory")
#define PG8_BAR __builtin_amdgcn_s_barrier()
#define PG8_SCHED __builtin_amdgcn_sched_barrier(0)
    Unit cur, nxt; int ui = 0;
    if (!S.next(0, cur)) return;
    f32x4 acc[2][2][4][2];
#pragma unroll
    for (int a = 0; a < 2; ++a)
#pragma unroll
        for (int b = 0; b < 2; ++b)
#pragma unroll
            for (int m = 0; m < 4; ++m)
#pragma unroll
                for (int n = 0; n < 2; ++n) acc[a][b][m][n] = (f32x4){0.f, 0.f, 0.f, 0.f};
    h16x8 At[4][2], B0[2][2], B1[2][2];
    const char* cA = (const char*)g.A + (size_t)cur.pm * tstepA + (size_t)cur.pn * g.a_pn_bytes; const char* cB = (const char*)g.Bt + (size_t)cur.pn * tstepB;
    PG8_STAGE(PG8_SB(0, 0), cB, voffB); PG8_STAGE(PG8_SB(0, 1), cB + hstepB, voffB); PG8_STAGE(PG8_SA(0, 0), cA, voffA); PG8_STAGE(PG8_SA(0, 1), cA + hstepA, voffA);
    if (wr == 1) PG8_BAR;
    PG8_WAIT_V(2); PG8_BAR;
    PG8_STAGE(PG8_SB(1, 0), cB + kstep, voffB); PG8_STAGE(PG8_SA(1, 0), cA + kstep, voffA); PG8_STAGE(PG8_SB(1, 1), cB + hstepB + kstep, voffB);
    PG8_WAIT_V(6); PG8_BAR;
    for (;;) {
        const bool has_next = S.next(ui + 1, nxt);
        const char* nA = has_next ? (const char*)g.A + (size_t)nxt.pm * tstepA + (size_t)nxt.pn * g.a_pn_bytes : cA; const char* nB = has_next ? (const char*)g.Bt + (size_t)nxt.pn * tstepB : cB;
        for (int t = 0; t < nt; t += 2) {
            const bool last = (t == nt - 2);
            const char* a1 = cA + (size_t)(t + 1) * kstep;
            const char* a2 = last ? nA : cA + (size_t)(t + 2) * kstep; const char* b2 = last ? nB : cB + (size_t)(t + 2) * kstep;
            const char* a3 = a2 + kstep; const char* b3 = b2 + kstep;
            PG8_LDB(B0, 0, 0); PG8_LDB(B1, 0, 1); PG8_SCHED; PG8_LDA(At, 0, 0); PG8_STAGE(PG8_SA(1, 1), a1 + hstepA, voffA);
            PG8_WAIT_V(8); PG8_WAIT_L(0); PG8_BAR; PG8_MMA(0, 0, At, B0); PG8_MMA(0, 1, At, B1); PG8_BAR; PG8_SCHED;
            PG8_LDA(At, 0, 1); PG8_STAGE(PG8_SB(0, 0), b2, voffB); PG8_STAGE(PG8_SB(0, 1), b2 + hstepB, voffB); PG8_STAGE(PG8_SA(0, 0), a2, voffA);
            PG8_WAIT_V(8); PG8_WAIT_L(0); PG8_BAR; PG8_MMA(1, 0, At, B0); PG8_MMA(1, 1, At, B1); PG8_BAR; PG8_SCHED;
            PG8_LDB(B0, 1, 0); PG8_LDB(B1, 1, 1); PG8_SCHED; PG8_LDA(At, 1, 0); PG8_STAGE(PG8_SA(0, 1), a2 + hstepA, voffA);
            PG8_WAIT_V(8); PG8_WAIT_L(0); PG8_BAR; PG8_MMA(0, 0, At, B0); PG8_MMA(0, 1, At, B1); PG8_BAR; PG8_SCHED;
            PG8_LDA(At, 1, 1); PG8_STAGE(PG8_SB(1, 0), b3, voffB); PG8_STAGE(PG8_SB(1, 1), b3 + hstepB, voffB); PG8_STAGE(PG8_SA(1, 0), a3, voffA);
            PG8_WAIT_V(8); PG8_WAIT_L(0); PG8_BAR; PG8_MMA(1, 0, At, B0); PG8_MMA(1, 1, At, B1); PG8_BAR; PG8_SCHED;
        }
        if constexpr (ALIGN_EPI) { if (wr == 0) PG8_BAR; }
        E(acc, cur, wr, wc, fr, fq);
        if (!has_next) break;
#pragma unroll
        for (int a = 0; a < 2; ++a)
#pragma unroll
            for (int b = 0; b < 2; ++b)
#pragma unroll
                for (int m = 0; m < 4; ++m)
#pragma unroll
                    for (int n = 0; n < 2; ++n) acc[a][b][m][n] = (f32x4){0.f, 0.f, 0.f, 0.f};
        cur = nxt; cA = nA; cB = nB; ++ui;
        if constexpr (ALIGN_EPI) { if (wr == 1) PG8_BAR; }
    }
    PG8_WAIT_V(0);
    if constexpr (!ALIGN_EPI) { if (wr == 0) PG8_BAR; }
    PG8_BAR;
#undef PG8_SA
#undef PG8_SB
#undef PG8_STAGE
#undef PG8_LDA
#undef PG8_LDB
#undef PG8_MMA
#undef PG8_WAIT_V
#undef PG8_WAIT_L
#undef PG8_BAR
#undef PG8_SCHED
}

struct EpiInProj {
    static constexpr bool PERM = true;
    unsigned char* ws;
    __device__ __forceinline__ void operator()(const f32x4 (&acc)[2][2][4][2], const Unit& u, int wr, int wc, int fr, int fq) const {
        const int row0 = u.pm * BM + wr * 64 + fr;
        const int pn = u.pn;
#pragma unroll
        for (int bj = 0; bj < 2; ++bj) {
            const int c0 = pn * BM + bj * HALF + wc * 32 + 8 * fq;
            size_t boff; int pitch, cb;
            if (pn < 4) { boff = WS_ZP; pitch = 1024; cb = 0; }
            else if (pn < 8) { boff = WS_Q; pitch = 1024; cb = 1024; }
            else if (pn == 8) { boff = WS_K; pitch = 256; cb = 2048; }
            else if (pn == 9) { boff = WS_V; pitch = 256; cb = 2304; }
            else if (pn < 18) { boff = WS_IDXQ; pitch = 2048; cb = 2560; }
            else { boff = WS_IDXK; pitch = 128; cb = 4608; }
            if (pn == 18 && bj == 1) {
                const int cw = c0 - 4736;
                if (cw >= 0 && cw < 16) {
                    float* idxw = (float*)(ws + WS_IDXW);
#pragma unroll
                    for (int ai = 0; ai < 2; ++ai)
#pragma unroll
                        for (int m = 0; m < 4; ++m) { float* p = idxw + (size_t)(row0 + ai * HALF + m * 16) * 16 + cw;
                            *(f32x4*)p = acc[ai][bj][m][0]; *(f32x4*)(p + 4) = acc[ai][bj][m][1]; }
                }
            } else {
                f16* base = (f16*)(ws + boff);
#pragma unroll
                for (int ai = 0; ai < 2; ++ai)
#pragma unroll
                    for (int m = 0; m < 4; ++m) { const f32x4 v0 = acc[ai][bj][m][0], v1 = acc[ai][bj][m][1];
                        u32x4 w; w.x = pkh(v0[0], v0[1]); w.y = pkh(v0[2], v0[3]); w.z = pkh(v1[0], v1[1]); w.w = pkh(v1[2], v1[3]);
                        *(u32x4*)(base + (size_t)(row0 + ai * HALF + m * 16) * pitch + (c0 - cb)) = w; }
            }
        }
    }
};
struct EpiPool {
    static constexpr bool PERM = true;
    f16* out; const float* pscale;
    __device__ __forceinline__ void operator()(const f32x4 (&acc)[2][2][4][2], const Unit& u, int wr, int wc, int fr, int fq) const {
        const int row0 = u.pm * BM + wr * 64 + fr;
        f32x4 sv[2][2];
#pragma unroll
        for (int bj = 0; bj < 2; ++bj)
#pragma unroll
            for (int n = 0; n < 2; ++n) sv[bj][n] = *(const f32x4*)(pscale + u.pn * BM + bj * HALF + wc * 32 + 8 * fq + 4 * n);
#pragma unroll
        for (int ai = 0; ai < 2; ++ai)
#pragma unroll
            for (int m = 0; m < 4; ++m) { const int row = row0 + ai * HALF + m * 16;
#pragma unroll
                for (int bj = 0; bj < 2; ++bj) { const f32x4 v0 = acc[ai][bj][m][0] * sv[bj][0], v1 = acc[ai][bj][m][1] * sv[bj][1];
                    u32x4 w; w.x = pkh(v0[0], v0[1]); w.y = pkh(v0[2], v0[3]); w.z = pkh(v1[0], v1[1]); w.w = pkh(v1[2], v1[3]);
                    *(u32x4*)(out + (size_t)row * DM + u.pn * BM + bj * HALF + wc * 32 + 8 * fq) = w; } }
    }
};
struct EpiF32Ssq {
    static constexpr bool PERM = false;
    float* C; int ldc; float* part;
    __device__ __forceinline__ void operator()(const f32x4 (&acc)[2][2][4][2], const Unit& u, int wr, int wc, int fr, int fq) const {
        const int row0 = u.pm * BM + wr * 64 + fr, col0 = u.pn * BM + wc * 32 + 4 * fq;
#pragma unroll
        for (int ai = 0; ai < 2; ++ai)
#pragma unroll
            for (int m = 0; m < 4; ++m) { const int row = row0 + ai * HALF + m * 16; float* rowp = C + (size_t)row * ldc + col0; float ss = 0.f;
#pragma unroll
                for (int bj = 0; bj < 2; ++bj)
#pragma unroll
                    for (int n = 0; n < 2; ++n) { const f32x4 v = acc[ai][bj][m][n]; ss += (v[0] * v[0] + v[1] * v[1]) + (v[2] * v[2] + v[3] * v[3]); *(f32x4*)(rowp + bj * HALF + n * 16) = v; }
                ss += __shfl_xor(ss, 16); ss += __shfl_xor(ss, 32);
                if (fq == 0) part[(size_t)row * 32 + u.pn * 4 + wc] = ss; }
    }
};
struct EpiRelu2 {
    static constexpr bool PERM = true;
    f16* O; int ldc;
    __device__ __forceinline__ void operator()(const f32x4 (&acc)[2][2][4][2], const Unit& u, int wr, int wc, int fr, int fq) const {
        const int row0 = u.pm * BM + wr * 64 + fr, col0 = u.pn * BM + wc * 32 + 8 * fq;
#pragma unroll
        for (int ai = 0; ai < 2; ++ai)
#pragma unroll
            for (int m = 0; m < 4; ++m) { f16* rowp = O + (size_t)(row0 + ai * HALF + m * 16) * ldc + col0;
#pragma unroll
                for (int bj = 0; bj < 2; ++bj) { f32x4 v0 = acc[ai][bj][m][0], v1 = acc[ai][bj][m][1];
#pragma unroll
                    for (int j = 0; j < 4; ++j) { const float a = fmaxf(v0[j], 0.f), b = fmaxf(v1[j], 0.f); v0[j] = a * a; v1[j] = b * b; }
                    u32x4 w; w.x = pkh(v0[0], v0[1]); w.y = pkh(v0[2], v0[3]); w.z = pkh(v1[0], v1[1]); w.w = pkh(v1[2], v1[3]);
                    *(u32x4*)(rowp + bj * HALF) = w; } }
    }
};
}

namespace att {
constexpr int NW = 8, QBLK = 32, KVBLK = 64, QB = NW * QBLK, D = 128;
constexpr int QS = 1024, KS = 256, OS = 2048;
constexpr int SHM_V = KVBLK * D * 2, SHM_K = KVBLK * D * 2;
constexpr int LDS_WSF = 2 * SHM_V + 2 * SHM_K;
constexpr int LDS_MASK = LDS_WSF + NW * 64 * 4;
constexpr int MROW = 264;
constexpr int LDS_TOTAL = LDS_MASK + NW * 32 * MROW;
constexpr float SCALE = 0.08838834764831845f;
constexpr float THR = 8.f;
#define KSWZ(row, colB) ((row) * 256 + ((colB) ^ (((row) & 7) << 4)))
#define SBAR() __builtin_amdgcn_sched_barrier(0)
__device__ __forceinline__ int v_st(int k, int c) { const int kk = (k & ~0xC) | ((k & 4) << 1) | ((k & 8) >> 1); return ((kk >> 3) * 4 + (c >> 5)) * 512 + ((kk & 7) * 32 + (c & 31)) * 2; }
__device__ __forceinline__ int v_rd_base(int lane) { return ((lane & 3) << 3) | (((lane >> 2) & 3) << 6) | (((lane >> 4) & 1) << 5) | (((lane >> 5) & 1) << 8); }
constexpr int v_rd_off(int d0, int ks, int half) { return d0 * 512 + ks * 4096 + half * 2048; }
__device__ __forceinline__ int crow(int r, int hi) { return (r & 3) + 8 * (r >> 2) + 4 * hi; }
__device__ __forceinline__ h16x8 load8(const f16* p) { return *reinterpret_cast<const h16x8*>(p); }
__device__ __forceinline__ void apply_mask(f32x16& p, unsigned w, int hi) {
    const int ws = (int)(w >> (4 * hi));
#pragma unroll
    for (int r = 0; r < 16; ++r) { const int t = __builtin_amdgcn_sbfe(ws, (r & 3) + 8 * (r >> 2), 1); p[r] = __uint_as_float(__float_as_uint(p[r]) & (unsigned)t); }
}
__device__ __forceinline__ bool partialSM(f32x16& p0, f32x16& p1, float& m_reg, float& l_reg, float* al_l, int r32, unsigned w0, int hi) {
    float mn; bool resc;
    float pmax = p0[0];
#pragma unroll
    for (int r = 1; r < 16; ++r) pmax = fmaxf(pmax, p0[r]);
#pragma unroll
    for (int r = 0; r < 16; ++r) pmax = fmaxf(pmax, p1[r]);
    { auto rr = __builtin_amdgcn_permlane32_swap(__float_as_uint(pmax), __float_as_uint(pmax), false, false);
      pmax = fmaxf(__uint_as_float(rr[0]), __uint_as_float(rr[1])); }
    constexpr float C2 = 1.4426950408889634f * SCALE;
    if (__builtin_expect(__all((pmax - m_reg) * SCALE <= THR), 1)) { mn = m_reg; resc = false; }
    else { mn = fmaxf(m_reg, pmax); const float alpha = __builtin_amdgcn_exp2f((m_reg - mn) * C2); m_reg = mn; l_reg *= alpha; if (hi == 0) al_l[r32] = alpha; resc = true; }
    const float mnL = -mn * C2;
#pragma unroll
    for (int r = 0; r < 16; ++r) p0[r] = fmaf(p0[r], C2, mnL);
#pragma unroll
    for (int r = 0; r < 16; ++r) p1[r] = fmaf(p1[r], C2, mnL);
#pragma unroll
    for (int r = 0; r < 16; ++r) p0[r] = __builtin_amdgcn_exp2f(p0[r]);
    apply_mask(p0, w0, hi);
    return resc;
}
__device__ __forceinline__ void finishSM(f32x16& p0, f32x16& p1, float& l_reg, h16x8& pa0, h16x8& pa1, h16x8& pa2, h16x8& pa3, unsigned w1, int hi) {
#pragma unroll
    for (int r = 0; r < 16; ++r) p1[r] = __builtin_amdgcn_exp2f(p1[r]);
    apply_mask(p1, w1, hi);
    float ps = 0;
#pragma unroll
    for (int r = 0; r < 16; ++r) ps += p0[r];
#pragma unroll
    for (int r = 0; r < 16; ++r) ps += p1[r];
    { auto rr = __builtin_amdgcn_permlane32_swap(__float_as_uint(ps), __float_as_uint(ps), false, false);
      ps = __uint_as_float(rr[0]) + __uint_as_float(rr[1]); }
    l_reg += ps;
#define PK4(P, B_, OUT) do { unsigned a0 = pkh(P[B_+0], P[B_+1]), a1 = pkh(P[B_+2], P[B_+3]);                          \
        unsigned b0 = pkh(P[B_+4], P[B_+5]), b1 = pkh(P[B_+6], P[B_+7]);                                             \
        auto r0 = __builtin_amdgcn_permlane32_swap(a0, b0, false, false); auto r1 = __builtin_amdgcn_permlane32_swap(a1, b1, false, false); \
        u32x4 w = {r0[0], r1[0], r0[1], r1[1]}; OUT = *reinterpret_cast<h16x8*>(&w); } while (0)
    PK4(p0, 0, pa0); PK4(p0, 8, pa1); PK4(p1, 0, pa2); PK4(p1, 8, pa3);
#undef PK4
}
template <int KB>
__device__ __forceinline__ void qkt(f32x16& p0, f32x16& p1, const char* K_lds, int r32, int hi, const h16x8* qr) {
    p0 = f32x16{}; p1 = f32x16{};
    const char* kb[4];
#pragma unroll
    for (int dd = 0; dd < 4; ++dd) kb[dd] = K_lds + KB * SHM_K + KSWZ(r32, (dd * 16 + hi * 8) * 2);
#pragma unroll
    for (int d0 = 0; d0 < 8; ++d0) { const char* a = kb[d0 & 3] + (d0 >> 2) * 128;
        h16x8 b0 = *reinterpret_cast<const h16x8*>(a);
        h16x8 b1 = *reinterpret_cast<const h16x8*>(a + 32 * 256);
        p0 = __builtin_amdgcn_mfma_f32_32x32x16_f16(b0, qr[d0], p0, 0, 0, 0);
        p1 = __builtin_amdgcn_mfma_f32_32x32x16_f16(b1, qr[d0], p1, 0, 0, 0); }
}
template <int VB>
__device__ __forceinline__ void pv_tile(f32x16* o, int vb0, h16x8 pa0, h16x8 pa1, h16x8 pa2, h16x8 pa3) {
#define TRRD(dst, off) asm volatile("ds_read_b64_tr_b16 %0, %1 offset:%2" : "=&v"(dst) : "v"(vb0), "i"(off) : "memory")
#define HV(l, h) __builtin_bit_cast(h16x8, (short __attribute__((ext_vector_type(8)))){l[0], l[1], l[2], l[3], h[0], h[1], h[2], h[3]})
#define PV_D0(d0) do { s16x4 l0, l1, l2, l3, h0, h1, h2, h3; constexpr int b_ = VB * SHM_V + v_rd_off(d0, 0, 0); \
        TRRD(l0, b_); TRRD(h0, b_ + 2048); TRRD(l1, b_ + 4096); TRRD(h1, b_ + 6144); TRRD(l2, b_ + 8192); TRRD(h2, b_ + 10240); TRRD(l3, b_ + 12288); TRRD(h3, b_ + 14336); \
        asm volatile("s_waitcnt lgkmcnt(0)" ::: "memory"); SBAR();   \
        o[d0] = __builtin_amdgcn_mfma_f32_32x32x16_f16(pa0, HV(l0, h0), o[d0], 0, 0, 0);   \
        o[d0] = __builtin_amdgcn_mfma_f32_32x32x16_f16(pa1, HV(l1, h1), o[d0], 0, 0, 0);   \
        o[d0] = __builtin_amdgcn_mfma_f32_32x32x16_f16(pa2, HV(l2, h2), o[d0], 0, 0, 0);   \
        o[d0] = __builtin_amdgcn_mfma_f32_32x32x16_f16(pa3, HV(l3, h3), o[d0], 0, 0, 0); } while (0)
    PV_D0(0); PV_D0(1); PV_D0(2); PV_D0(3);
#undef PV_D0
#undef HV
#undef TRRD
}
struct BlockRef { const f16* Q; const f16* K; const f16* V; f16* O; const unsigned* mrows; int P0; };
struct Seam { h16x8 qr[8]; h16x8 st_v0, st_v1, st_k0, st_k1; };
#define ROW(p, k0, rr) ((p) + (size_t)((k0) + (rr)) * KS + sc)
#define VMW() asm volatile("s_waitcnt vmcnt(0)" ::: "memory")
#define VMWN(n) asm volatile("s_waitcnt vmcnt(%0)" :: "i"(n) : "memory")
#define SLOAD_H(Kp, Vp, k0) do { S.st_v0 = load8(ROW(Vp, k0, sr)); S.st_v1 = load8(ROW(Vp, k0, 32 + sr));              \
                         S.st_k0 = load8(ROW(Kp, k0, sr)); S.st_k1 = load8(ROW(Kp, k0, 32 + sr)); } while (0)
#define SWRITE_HK(bf) do { *(h16x8*)(K_lds + (bf) * SHM_K + kws) = S.st_k0; *(h16x8*)(K_lds + (bf) * SHM_K + kws + 32 * 256) = S.st_k1; } while (0)
#define SWRITE_HV(bf) do { *(h16x8*)(V_lds + (bf) * SHM_V + vst0) = S.st_v0; *(h16x8*)(V_lds + (bf) * SHM_V + vst1) = S.st_v1; } while (0)
#define SWRITE_H(bf) do { SWRITE_HV(bf); SWRITE_HK(bf); } while (0)
__device__ __forceinline__ void attn_prime(const BlockRef& cur, char* lds, Seam& S) {
    const int tid = threadIdx.x, wid = __builtin_amdgcn_readfirstlane(tid >> 6), lane = tid & 63, r32 = lane & 31, hi = lane >> 5;
    const int sr = tid >> 4, sc = (tid & 15) * 8, kws = KSWZ(sr, sc * 2); char* K_lds = lds + 2 * SHM_V;
#pragma unroll
    for (int d0 = 0; d0 < 8; ++d0) S.qr[d0] = load8(cur.Q + (size_t)(wid * QBLK + r32) * QS + d0 * 16 + hi * 8);
    SLOAD_H(cur.K, cur.V, 0); VMW(); SWRITE_HK(0);
    __syncthreads();
}
__device__ __forceinline__ void attn_block(const BlockRef& cur, const BlockRef& nxt, char* lds, Seam& S) {
    const int tid = threadIdx.x, wid = __builtin_amdgcn_readfirstlane(tid >> 6), lane = tid & 63, r32 = lane & 31, hi = lane >> 5;
    const int NT = (cur.P0 + QB) / KVBLK;
    char* V_lds = lds; char* K_lds = lds + 2 * SHM_V;
    float* ws = (float*)(lds + LDS_WSF) + wid * 64; float* li_l = ws, * al_l = ws + 32;
    { LAS unsigned* mr = (LAS unsigned*)((LAS char*)lds + LDS_MASK + wid * 32 * MROW);
      const unsigned* src = cur.mrows + (size_t)(wid * QBLK) * 64 + lane;
#pragma unroll 8
      for (int rr = 0; rr < 32; ++rr) mr[rr * (MROW / 4) + lane] = src[(size_t)rr * 64];
    }
    const LAS unsigned* mrow = (const LAS unsigned*)((LAS char*)lds + LDS_MASK + wid * 32 * MROW + r32 * MROW);
    float m_reg = -1e30f, l_reg = 0; f32x16 o[4] = {};
    const int sr = tid >> 4, sc = (tid & 15) * 8, vst0 = v_st(sr, sc), vst1 = v_st(32 + sr, sc), kws = KSWZ(sr, sc * 2);
    const int vb0 = (int)(uintptr_t)V_lds + v_rd_base(lane);
    const f16* Kh = cur.K; const f16* Vh = cur.V;
#define RESC(a) do { if (a) { asm volatile("s_waitcnt lgkmcnt(0)" ::: "memory");              \
                     for (int d_ = 0; d_ < 4; ++d_) for (int r = 0; r < 16; ++r) o[d_][r] *= al_l[crow(r, hi)]; } } while (0)
#define KBASE(t) ((t) * KVBLK)
#define SEAM_K0() do { VMWN(8); SWRITE_HK(0); SBAR(); } while (0)
    f32x16 pA0, pA1, pB0, pB1; bool alA, alB; h16x8 pa0, pa1, pa2, pa3;
    SWRITE_HV(0); SBAR();
    if (NT > 1) { SLOAD_H(Kh, Vh, KBASE(1)); }
    SBAR(); qkt<0>(pA0, pA1, K_lds, r32, hi, S.qr);
    alA = partialSM(pA0, pA1, m_reg, l_reg, al_l, r32, mrow[0], hi); (void)alA;
    if (NT > 1) { VMW(); SWRITE_H(1); }
    __syncthreads();
#define HALF_STEP(PX0, PX1, alX, PY0, PY1, t, KB, VB, SB) do {                                                      \
        SBAR(); qkt<KB>(PX0, PX1, K_lds, r32, hi, S.qr);                                                                      \
        finishSM(PY0, PY1, l_reg, pa0, pa1, pa2, pa3, mrow[2 * ((t) - 1) + 1], hi); SBAR();                               \
        if ((t) + 1 < NT) { SLOAD_H(Kh, Vh, KBASE((t) + 1)); SBAR(); }                                                        \
        pv_tile<VB>(o, vb0, pa0, pa1, pa2, pa3); alX = partialSM(PX0, PX1, m_reg, l_reg, al_l, r32, mrow[2 * (t)], hi);                      \
        __syncthreads();                                                                                                      \
        if ((t) + 1 < NT) { VMW(); SWRITE_H(SB); }                                                                            \
        RESC(alX); __syncthreads(); } while (0)
    for (int t = 1; t + 1 < NT; t += 2) {
        HALF_STEP(pB0, pB1, alB, pA0, pA1, t, 1, 0, 0);
        HALF_STEP(pA0, pA1, alA, pB0, pB1, t + 1, 0, 1, 1);
    }
    SBAR(); qkt<1>(pB0, pB1, K_lds, r32, hi, S.qr); SBAR();
    SLOAD_H(nxt.K, nxt.V, 0); SBAR();
#pragma unroll
    for (int d0 = 0; d0 < 8; ++d0) S.qr[d0] = load8(nxt.Q + (size_t)(wid * QBLK + r32) * QS + d0 * 16 + hi * 8);
    SBAR();
    finishSM(pA0, pA1, l_reg, pa0, pa1, pa2, pa3, mrow[2 * (NT - 2) + 1], hi); SBAR();
    pv_tile<0>(o, vb0, pa0, pa1, pa2, pa3);
    alB = partialSM(pB0, pB1, m_reg, l_reg, al_l, r32, mrow[2 * (NT - 1)], hi); __syncthreads(); RESC(alB);
    finishSM(pB0, pB1, l_reg, pa0, pa1, pa2, pa3, mrow[2 * (NT - 1) + 1], hi); SBAR(); pv_tile<1>(o, vb0, pa0, pa1, pa2, pa3);
    SBAR(); SEAM_K0();
    if (hi == 0) li_l[r32] = l_reg; asm volatile("s_waitcnt lgkmcnt(0)" ::: "memory");
    float rli[16];
#pragma unroll
    for (int r = 0; r < 16; ++r) rli[r] = __builtin_amdgcn_rcpf(li_l[crow(r, hi)]);
    f16* Ow = cur.O + (size_t)(wid * QBLK) * OS;
#pragma unroll
    for (int r = 0; r < 16; ++r) { const int orow = crow(r, hi);
#pragma unroll
        for (int d0 = 0; d0 < 4; ++d0) { const float v = o[d0][r] * rli[r];
            const float vn = __shfl_xor(v, 1);
            if ((r32 & 1) == 0) *(unsigned*)(Ow + (size_t)orow * OS + d0 * 32 + r32) = pkh(v, vn); } }
    __syncthreads();
#undef RESC
#undef KBASE
#undef SEAM_K0
#undef HALF_STEP
}
#undef ROW
#undef VMW
#undef VMWN
#undef SLOAD_H
#undef SWRITE_HK
#undef SWRITE_HV
#undef SWRITE_H
#undef KSWZ
#undef SBAR
}

#define XB_TMO      128
#define XB_XCNT(j)  (256  + 64 * (j))
#define XB_XSUB(j)  (1280 + 64 * (j))
#define XB_XGEN(j)  (2304 + 64 * (j))
#define XB_TOP      3328
#define XB_TOPGEN   3392
#define XCD_BAR_WORDS 3456
#define XB_SPIN_CAP (1u << 20)
__device__ __forceinline__ unsigned xb_ld(unsigned* p)              { return __hip_atomic_load(p, __ATOMIC_RELAXED, __HIP_MEMORY_SCOPE_AGENT); }
__device__ __forceinline__ unsigned xb_add(unsigned* p, unsigned v) { return __hip_atomic_fetch_add(p, v, __ATOMIC_RELAXED, __HIP_MEMORY_SCOPE_AGENT); }
__device__ __forceinline__ unsigned xb_xcc_id() { return (unsigned)__builtin_amdgcn_s_getreg((3 << 11) | 20) & 0xFu; }
#define XB_SPIN(cond, bar) do { unsigned _sp = 0; while (cond) { __builtin_amdgcn_s_sleep(1); \
    if ((++_sp & 255u) == 0u) { if (xb_ld(&(bar)[XB_TMO])) break; if (_sp > XB_SPIN_CAP) { atomicAdd(&(bar)[XB_TMO], 1u); break; } } } } while (0)
struct XcdBarrier { unsigned* bar; unsigned x; volatile LAS unsigned* st; };
__device__ __forceinline__ XcdBarrier xcd_barrier_post(unsigned* bar, volatile LAS unsigned* st) {
    XcdBarrier b; b.bar = bar; b.x = xb_xcc_id(); b.st = st;
    if (threadIdx.x == 0) (void)xb_add(&bar[XB_XCNT(b.x)], 1u);
    return b;
}
__device__ __forceinline__ void xcd_barrier_complete(unsigned* bar, unsigned x, unsigned& nloc, unsigned& nx) {
    const unsigned G = gridDim.x * gridDim.y * gridDim.z;
    unsigned sum, cnt, mine, sp = 0u;
    for (;;) {
        sum = 0u; cnt = 0u; mine = 0u;
#pragma unroll
        for (unsigned j = 0; j < 16; ++j) { const unsigned c = xb_ld(&bar[XB_XCNT(j)]); sum += c; cnt += (c > 0u) ? 1u : 0u; mine = (j == x) ? c : mine; }
        if (sum == G) break;
        __builtin_amdgcn_s_sleep(1);
        if ((++sp & 255u) == 0u) { if (xb_ld(&bar[XB_TMO])) break; if (sp > XB_SPIN_CAP) { atomicAdd(&bar[XB_TMO], 1u); break; } }
    }
    nloc = mine > 0u ? mine : 1u; nx = cnt > 0u ? cnt : 1u;
}
__device__ __forceinline__ void xcd_barrier(const XcdBarrier& b) {
    asm volatile("s_waitcnt vmcnt(0)" ::: "memory");
    __syncthreads();
    if (threadIdx.x == 0) {
        unsigned* bar = b.bar;
        __builtin_amdgcn_s_waitcnt(0);
        unsigned nloc = b.st[0], nx = b.st[1];
        if (nloc == 0u) { xcd_barrier_complete(bar, b.x, nloc, nx); b.st[0] = nloc; b.st[1] = nx; }
        const unsigned old = xb_add(&bar[XB_XSUB(b.x)], 1u);
        const unsigned gen = old / nloc;
        if (old + 1u == (gen + 1u) * nloc) {
            __builtin_amdgcn_fence(__ATOMIC_RELEASE, "agent");
            asm volatile("s_waitcnt vmcnt(0)" ::: "memory");
            const unsigned og = xb_add(&bar[XB_TOP], 1u);
            const unsigned tg = og / nx;
            if (og + 1u == (tg + 1u) * nx) xb_add(&bar[XB_TOPGEN], 1u);
            else XB_SPIN(xb_ld(&bar[XB_TOPGEN]) == tg, bar);
            __builtin_amdgcn_fence(__ATOMIC_ACQUIRE, "agent");
            xb_add(&bar[XB_XGEN(b.x)], 1u);
            asm volatile("s_waitcnt vmcnt(0)" ::: "memory");
        } else {
            XB_SPIN(xb_ld(&bar[XB_XGEN(b.x)]) == gen, bar);
            __builtin_amdgcn_fence(__ATOMIC_ACQUIRE, "agent");
            asm volatile("s_waitcnt vmcnt(0)" ::: "memory");
        }
    }
    __syncthreads();
}

struct Args { const float* in[16]; float* out; unsigned char* ws; int ph_lo, ph_hi; };
#define CAS __attribute__((address_space(4)))
__device__ __forceinline__ int fresh_tid() { int t = threadIdx.x; asm volatile("" : "+v"(t)); return t; }
#define PHASE_IDS const int tid_ = fresh_tid(), lane_ = tid_ & 63, wave_ = __builtin_amdgcn_readfirstlane(tid_ >> 6); (void)lane_; (void)wave_
struct Frame {
    LAS unsigned char* lds; unsigned char* ldsg;
    int vcu, G;
    const CAS Args* ap;
    float* out; unsigned char* ws;
};
__device__ __forceinline__ float mod_at(const Frame& F, int b, int e) { return ((const float*)(F.ws + CTL_MODACC))[b * (6 * DM) + e] + (F.ap->in[3])[e]; }

__device__ __forceinline__ void transpose_item(const float* W, int K, int N, f16* WT, LAS float* scr, int item, int lane) {
    const int nblk = (N + 31) / 32, kb = item / nblk, nb = item % nblk, k0 = 64 * kb, n0 = 32 * nb;
    const int col = n0 + (lane & 31); const bool cok = col < N;
#pragma unroll 8
    for (int i = 0; i < 32; ++i) { const int kk = 2 * i + (lane >> 5); scr[kk * 33 + (lane & 31)] = cok ? W[(size_t)(k0 + kk) * N + col] : 0.f; }
    LDS_WAIT(); asm volatile("" ::: "memory");
    const int c = lane & 7;
#pragma unroll
    for (int j = 0; j < 4; ++j) { const int n = (lane >> 3) + 8 * j; const LAS float* s = scr + (8 * c) * 33 + n;
        u32x4 o; o.x = pkh(s[0 * 33], s[1 * 33]); o.y = pkh(s[2 * 33], s[3 * 33]); o.z = pkh(s[4 * 33], s[5 * 33]); o.w = pkh(s[6 * 33], s[7 * 33]);
        if (n0 + n < N) *(u32x4*)(WT + (size_t)(n0 + n) * K + k0 + 8 * c) = o; }
    LDS_WAIT(); asm volatile("" ::: "memory");
}
__device__ __forceinline__ void p0_prologue(Frame& F) {
    PHASE_IDS;
    LAS float* scr = (LAS float*)(F.lds + wave_ * 8704);
    LAS float* cact = (LAS float*)(F.lds + 8 * 8704);
    for (int i = tid_; i < NB * DM; i += NTHREADS) { const float v = (F.ap->in[1])[i]; cact[i] = v / (1.f + __expf(-v)); }
    __syncthreads();
    const int gw = F.vcu * NWAVES + wave_, NGW = F.G * NWAVES;
    float* macc = (float*)(F.ws + CTL_MODACC);
    constexpr int NADA = 48 * 32;
    for (int it = gw; it < NADA; it += NGW) {
        const int cb = it % 48, kc = it / 48, col = cb * 256 + lane_ * 4;
        f32x4 a0 = {0, 0, 0, 0}, a1 = a0, a2 = a0, a3 = a0;
        const float* wp = (F.ap->in[2]) + (size_t)(kc * 64) * (6 * DM) + col;
#pragma unroll 8
        for (int d = 0; d < 64; ++d) { const f32x4 wv = *(const f32x4*)(wp + (size_t)d * (6 * DM)); const int dd = kc * 64 + d;
            a0 += wv * cact[dd]; a1 += wv * cact[DM + dd]; a2 += wv * cact[2 * DM + dd]; a3 += wv * cact[3 * DM + dd]; }
#pragma unroll
        for (int j = 0; j < 4; ++j) {
            __hip_atomic_fetch_add(macc + 0 * 6 * DM + col + j, a0[j], __ATOMIC_RELAXED, __HIP_MEMORY_SCOPE_AGENT);
            __hip_atomic_fetch_add(macc + 1 * 6 * DM + col + j, a1[j], __ATOMIC_RELAXED, __HIP_MEMORY_SCOPE_AGENT);
            __hip_atomic_fetch_add(macc + 2 * 6 * DM + col + j, a2[j], __ATOMIC_RELAXED, __HIP_MEMORY_SCOPE_AGENT);
            __hip_atomic_fetch_add(macc + 3 * 6 * DM + col + j, a3[j], __ATOMIC_RELAXED, __HIP_MEMORY_SCOPE_AGENT); }
    }
    constexpr int I_IN = (DM / 64) * ((INW + 31) / 32), I_OUT = (DM / 64) * (DM / 32), I_1 = (DM / 64) * (FF / 32), I_2 = (FF / 64) * (DM / 32), I_P = 4 * (256 / 64) * (256 / 32);
    constexpr int NITEMS = I_IN + I_OUT + I_1 + I_2 + I_P;
    for (int it = gw; it < NITEMS; it += NGW) {
        int r = it;
        if (r < I_IN) { transpose_item((F.ap->in[8]), DM, INW, (f16*)(F.ws + WS_WIN), scr, r, lane_); continue; } r -= I_IN;
        if (r < I_OUT) { transpose_item((F.ap->in[13]), DM, DM, (f16*)(F.ws + WS_WOUT), scr, r, lane_); continue; } r -= I_OUT;
        if (r < I_1) { transpose_item((F.ap->in[14]), DM, FF, (f16*)(F.ws + WS_WFF1), scr, r, lane_); continue; } r -= I_1;
        if (r < I_2) { transpose_item((F.ap->in[15]), FF, DM, (f16*)(F.ws + WS_WFF2), scr, r, lane_); continue; } r -= I_2;
        { const int gi = r / 32; transpose_item((F.ap->in[9]) + (size_t)gi * 65536, 256, 256, (f16*)(F.ws + WS_WPOOL) + (size_t)gi * 65536, scr, r % 32, lane_); }
    }
}
__device__ __forceinline__ void p1_norm1(Frame& F) {
    PHASE_IDS;
    const int gw = F.vcu * NWAVES + wave_, NGW = F.G * NWAVES;
    f16* H = (f16*)(F.ws + WS_H);
    for (int m = gw; m < T; m += NGW) {
        const int b = m >> 11; const float* xr = (F.ap->in[0]) + (size_t)m * DM + lane_ * 4;
        f32x4 v[8]; float ss = 0.f;
#pragma unroll
        for (int j = 0; j < 8; ++j) { v[j] = *(const f32x4*)(xr + 256 * j); ss += (v[j][0] * v[j][0] + v[j][1] * v[j][1]) + (v[j][2] * v[j][2] + v[j][3] * v[j][3]); }
        const float rstd = rsqrtf(wave_sum(ss) * (1.f / DM) + RMS_EPS);
#pragma unroll
        for (int j = 0; j < 8; ++j) { const int col = lane_ * 4 + 256 * j; const f32x4 g = *(const f32x4*)((F.ap->in[4]) + col); float y[4];
#pragma unroll
            for (int e = 0; e < 4; ++e) y[e] = v[j][e] * rstd * g[e] * (1.f + mod_at(F, b, DM + col + e)) + mod_at(F, b, col + e);
            u32x2 w; w.x = pkh(y[0], y[1]); w.y = pkh(y[2], y[3]); *(u32x2*)(H + (size_t)m * DM + col) = w; }
    }
}
__device__ __forceinline__ void indexer_unit(Frame& F, int b, int qt, int kt_lo, int kt_hi) {
    PHASE_IDS;
    const f16* idxq = (const f16*)(F.ws + WS_IDXQ); const f16* idxk = (const f16*)(F.ws + WS_IDXK); const float* idxw = (const float*)(F.ws + WS_IDXW);
    float* scores = (float*)(F.ws + WS_SCORES);
    const int lane = lane_, r = lane & 31, hp = lane >> 5, wid = wave_, tid = tid_;
    const int tok0 = b * SEQ + qt * 32 + wid * 4;
    constexpr float idx_scale = 0.25f * 0.08838834764831845f;
    h16x8 a[2][8]; float wq[2][16];
#pragma unroll
    for (int tile = 0; tile < 2; ++tile) {
        const int query = tok0 + 2 * tile + ((r >> 2) & 1), head = (r & 3) + 4 * (r >> 3);
        const f16* p = idxq + (size_t)query * 2048 + head * 128 + 8 * hp;
#pragma unroll
        for (int s = 0; s < 8; ++s) a[tile][s] = *(const h16x8*)(p + 16 * s);
        const float* wp = idxw + (size_t)(tok0 + 2 * tile + hp) * 16;
#pragma unroll
        for (int j = 0; j < 4; ++j) { const f32x4 w4 = *(const f32x4*)(wp + 4 * j); wq[tile][4 * j] = w4[0] * idx_scale; wq[tile][4 * j + 1] = w4[1] * idx_scale; wq[tile][4 * j + 2] = w4[2] * idx_scale; wq[tile][4 * j + 3] = w4[3] * idx_scale; }
    }
    for (int kt = kt_lo; kt < kt_hi; kt += 2) {
        const int ntile = (kt_hi - kt) < 2 ? (kt_hi - kt) : 2;
        __syncthreads();
#pragma unroll
        for (int p = 0; p < 2; ++p) { const int row = p * 32 + (tid >> 4), c = tid & 15; int key = kt * 32 + row; key = key < SEQ ? key : SEQ - 1;
            const u32x4 v = *(const u32x4*)(idxk + (size_t)(b * SEQ + key) * 128 + c * 8);
            *(LAS u32x4*)(F.lds + row * 256 + ((c ^ (row & 15)) << 4)) = v; }
        __syncthreads();
        for (int tt = 0; tt < ntile; ++tt) {
            h16x8 bf[8];
#pragma unroll
            for (int s = 0; s < 8; ++s) { const int c = 2 * s + hp; bf[s] = *(const LAS h16x8*)(F.lds + (tt * 32 + r) * 256 + ((c ^ (r & 15)) << 4)); }
#pragma unroll
            for (int tile = 0; tile < 2; ++tile) {
                f32x16 acc = {};
#pragma unroll
                for (int s = 0; s < 8; ++s) acc = __builtin_amdgcn_mfma_f32_32x32x16_f16(a[tile][s], bf[s], acc, 0, 0, 0);
                float sc = 0.f;
#pragma unroll
                for (int g = 0; g < 16; ++g) sc = fmaf(wq[tile][g], fmaxf(acc[g], 0.f), sc);
                scores[(size_t)(tok0 + 2 * tile + hp) * SEQ + (kt + tt) * 32 + r] = sc;
            }
        }
    }
}
__device__ __forceinline__ void p3_indexer(Frame& F) {
    for (int c = F.vcu; c < 256; c += F.G) {
        const int b = c >> 6, i = c & 63;
        indexer_unit(F, b, i, 0, (i + 2) / 2);
        const int j = 63 - i;
        indexer_unit(F, b, j, (j + 2) / 2, j + 1);
    }
}
__device__ __forceinline__ void p3_pooled(Frame& F) {
    PHASE_IDS;
    const f16* zp = (const f16*)(F.ws + WS_ZP); f16* pooled = (f16*)(F.ws + WS_POOLED);
    const int gt = F.vcu * NTHREADS + tid_, NGT = F.G * NTHREADS;
    for (int it = gt; it < T * 128; it += NGT) {
        const int row = it >> 7, ch = (it & 127) * 8, tpos = row & (SEQ - 1), win = 2 << (ch >> 8);
        const int cnt = (tpos + 1) < win ? (tpos + 1) : win;
        float s[8] = {0, 0, 0, 0, 0, 0, 0, 0}; float u[8];
        for (int w = 0; w < cnt; ++w) { const h16x8 v = *(const h16x8*)(zp + (size_t)(row - w) * 1024 + ch);
#pragma unroll
            for (int e = 0; e < 8; ++e) { const float f = (float)v[e]; s[e] += f; if (w == 0) u[e] = f; } }
        const float inv = 1.f / (float)cnt;
        u32x4 o; o.x = pkh(s[0] * inv - u[0], s[1] * inv - u[1]); o.y = pkh(s[2] * inv - u[2], s[3] * inv - u[3]); o.z = pkh(s[4] * inv - u[4], s[5] * inv - u[5]); o.w = pkh(s[6] * inv - u[6], s[7] * inv - u[7]);
        *(u32x4*)(pooled + (size_t)row * 1024 + ch) = o;
    }
}
__device__ __forceinline__ unsigned mono_key(float f) { const unsigned u = __float_as_uint(f); return (u & 0x80000000u) ? ~u : (u | 0x80000000u); }
__device__ __forceinline__ void p4_select(Frame& F) {
    PHASE_IDS;
    const float* scores = (const float*)(F.ws + WS_SCORES); unsigned* maskbits = (unsigned*)(F.ws + WS_MASK);
    const int gw = F.vcu * NWAVES + wave_, NGW = F.G * NWAVES, lane = lane_;
    for (int row = gw; row < T; row += NGW) {
        const int t = row & (SEQ - 1);
        unsigned myword;
        if (t < TOPK) {
            const int lo = 32 * lane; myword = (lo + 31 <= t) ? 0xFFFFFFFFu : (lo > t ? 0u : ((1u << (t - lo + 1)) - 1u));
        } else {
            unsigned u[32];
            const float* sr = scores + (size_t)row * SEQ + lane;
#pragma unroll
            for (int i = 0; i < 32; ++i) { const int key = 64 * i + lane; u[i] = 0u; if (64 * i <= t) { const float f = sr[64 * i]; u[i] = key <= t ? mono_key(f) : 0u; } }
            unsigned Tv = 0u; int cge = 0; bool exact = false;
            for (int bit = 31; bit >= 0; --bit) {
                const unsigned cand = Tv | (1u << bit); int cl = 0;
#pragma unroll
                for (int i = 0; i < 32; ++i) cl += (u[i] >= cand) ? 1 : 0;
                const int c = wave_sum_i(cl);
                if (c >= TOPK) { Tv = cand; cge = c; if (c == TOPK) { exact = true; break; } }
            }
            myword = 0u;
            if (exact || cge == TOPK) {
#pragma unroll
                for (int i = 0; i < 32; ++i) { const unsigned long long bal = __ballot(u[i] >= Tv); if ((lane >> 1) == i) myword = (lane & 1) ? (unsigned)(bal >> 32) : (unsigned)bal; if ((i & 3) == 3) __builtin_amdgcn_sched_barrier(0); }
            } else {
                int cgt = 0;
#pragma unroll
                for (int i = 0; i < 32; ++i) { cgt += __builtin_popcountll(__ballot(u[i] > Tv)); if ((i & 7) == 7) __builtin_amdgcn_sched_barrier(0); }
                int need = TOPK - cgt;
#pragma unroll
                for (int i = 0; i < 32; ++i) {
                    unsigned long long bal = __ballot(u[i] > Tv); unsigned long long eq = __ballot(u[i] == Tv);
                    while (eq != 0ull && need > 0) { const unsigned long long lowbit = eq & (~eq + 1ull); bal |= lowbit; eq ^= lowbit; --need; }
                    if ((lane >> 1) == i) myword = (lane & 1) ? (unsigned)(bal >> 32) : (unsigned)bal;
                    __builtin_amdgcn_sched_barrier(0);
                }
            }
        }
        maskbits[(size_t)row * 64 + lane] = myword;
    }
}
__device__ __forceinline__ void p6_norm_merged(Frame& F) {
    PHASE_IDS;
    const int gw = F.vcu * NWAVES + wave_, NGW = F.G * NWAVES, lane = lane_;
    f16* M = (f16*)(F.ws + WS_MRAW);
    for (int m = gw; m < T; m += NGW) {
        h16x8 v[4]; float sp = 0.f, sa = 0.f;
#pragma unroll
        for (int j = 0; j < 4; ++j) { v[j] = *(const h16x8*)(M + (size_t)m * DM + lane * 8 + 512 * j); float s = 0.f;
#pragma unroll
            for (int e = 0; e < 8; ++e) { const float f = (float)v[j][e]; s += f * f; }
            if (j < 2) sp += s; else sa += s; }
        sp = wave_sum(sp); sa = wave_sum(sa);
        const float rp = rsqrtf(sp * (1.f / 1024.f) + RMS_EPS), ra = rsqrtf(sa * (1.f / 1024.f) + RMS_EPS);
#pragma unroll
        for (int j = 0; j < 4; ++j) { const int col = lane * 8 + 512 * j; f16* p = M + (size_t)m * DM + col;
            const float rs = j < 2 ? rp : ra; const float* g = j < 2 ? (F.ap->in[11]) + col : (F.ap->in[12]) + (col - 1024);
            const f32x4 g0 = *(const f32x4*)g, g1 = *(const f32x4*)(g + 4);
            u32x4 o; o.x = pkh((float)v[j][0] * rs * g0[0], (float)v[j][1] * rs * g0[1]); o.y = pkh((float)v[j][2] * rs * g0[2], (float)v[j][3] * rs * g0[3]);
            o.z = pkh((float)v[j][4] * rs * g1[0], (float)v[j][5] * rs * g1[1]); o.w = pkh((float)v[j][6] * rs * g1[2], (float)v[j][7] * rs * g1[3]);
            *(u32x4*)p = o; }
    }
}
__device__ __forceinline__ void p8_rowpass(Frame& F) {
    PHASE_IDS;
    const int gw = F.vcu * NWAVES + wave_, NGW = F.G * NWAVES, lane = lane_;
    const float* mix = (const float*)(F.ws + WS_MIX); const float* pm = (const float*)(F.ws + WS_PART); f16* H = (f16*)(F.ws + WS_H);
    for (int m = gw; m < T; m += NGW) {
        const int b = m >> 11;
        float sm = lane < 32 ? pm[(size_t)m * 32 + lane] : 0.f; sm = wave_sum(sm);
        const float rm = rsqrtf(sm * (1.f / DM) + RMS_EPS);
        f32x4 x1[8]; float ss = 0.f;
#pragma unroll
        for (int j = 0; j < 8; ++j) { const int col = lane * 4 + 256 * j; const f32x4 xv = *(const f32x4*)((F.ap->in[0]) + (size_t)m * DM + col), mv = *(const f32x4*)(mix + (size_t)m * DM + col), g = *(const f32x4*)((F.ap->in[5]) + col);
#pragma unroll
            for (int e = 0; e < 4; ++e) { x1[j][e] = xv[e] + mod_at(F, b, 2 * DM + col + e) * (mv[e] * rm * g[e]); ss += x1[j][e] * x1[j][e]; }
            *(f32x4*)(F.out + (size_t)m * DM + col) = x1[j]; }
        const float r1 = rsqrtf(wave_sum(ss) * (1.f / DM) + RMS_EPS);
#pragma unroll
        for (int j = 0; j < 8; ++j) { const int col = lane * 4 + 256 * j; const f32x4 g = *(const f32x4*)((F.ap->in[6]) + col); float y[4];
#pragma unroll
            for (int e = 0; e < 4; ++e) y[e] = x1[j][e] * r1 * g[e] * (1.f + mod_at(F, b, 4 * DM + col + e)) + mod_at(F, b, 3 * DM + col + e);
            u32x2 w; w.x = pkh(y[0], y[1]); w.y = pkh(y[2], y[3]); *(u32x2*)(H + (size_t)m * DM + col) = w; }
    }
}
__device__ __forceinline__ void p11_final(Frame& F) {
    PHASE_IDS;
    const int gw = F.vcu * NWAVES + wave_, NGW = F.G * NWAVES, lane = lane_;
    const float* f2 = (const float*)(F.ws + WS_F2); const float* pf = (const float*)(F.ws + WS_PART) + (size_t)T * 32;
    for (int m = gw; m < T; m += NGW) {
        const int b = m >> 11;
        float sf = lane < 32 ? pf[(size_t)m * 32 + lane] : 0.f; sf = wave_sum(sf);
        const float rf = rsqrtf(sf * (1.f / DM) + RMS_EPS);
#pragma unroll
        for (int j = 0; j < 8; ++j) { const int col = lane * 4 + 256 * j; float* op = F.out + (size_t)m * DM + col;
            const f32x4 xv = *(const f32x4*)op, fv = *(const f32x4*)(f2 + (size_t)m * DM + col), g = *(const f32x4*)((F.ap->in[7]) + col); f32x4 o;
#pragma unroll
            for (int e = 0; e < 4; ++e) o[e] = xv[e] + mod_at(F, b, 5 * DM + col + e) * (fv[e] * rf * g[e]);
            *(f32x4*)op = o; }
    }
}

constexpr int NPHASE = 12;
__global__ void __launch_bounds__(NTHREADS, 2) hymba_fwd(Args args) {
    extern __shared__ __attribute__((aligned(16))) unsigned char lds[];
    Frame F;
    F.lds = (LAS unsigned char*)lds; F.ldsg = lds;
    F.G = gridDim.x; { const int bx = blockIdx.x; F.vcu = (F.G % 8 == 0) ? (bx % 8) * (F.G / 8) + bx / 8 : bx; }
    F.ap = (const CAS Args*)__builtin_amdgcn_kernarg_segment_ptr();
    F.out = args.out; F.ws = args.ws;
    volatile LAS unsigned* MISC = (volatile LAS unsigned*)(F.lds + MISC_OFF);
    if (threadIdx.x < 128) MISC[threadIdx.x] = 0u;
    __syncthreads();
    const int lo = args.ph_lo, hi = args.ph_hi;
    XcdBarrier bar; bar.bar = (unsigned*)(F.ws + WS_CTL) + CW_BAR; bar.x = 0; bar.st = nullptr;
    if (hi - lo > 1) bar = xcd_barrier_post((unsigned*)(F.ws + WS_CTL) + CW_BAR, MISC + 8);
#ifndef PHASE_MASK
#define PHASE_MASK 0xFFF
#endif
#define IN(k) (((PHASE_MASK >> (k)) & 1) && lo <= (k) && (k) < hi)
#define SEAM(k) do { if (IN(k) && IN((k) + 1)) xcd_barrier(bar); } while (0)
    float* part = (float*)(F.ws + WS_PART);
    if (IN(0)) { p0_prologue(F); SEAM(0); }
    if (IN(1)) { p1_norm1(F); SEAM(1); }
    if (IN(2)) {
        pg8::Gemm g{(const f16*)(F.ws + WS_H), (const f16*)(F.ws + WS_WIN), DM, DM, DM, 0}; pg8::StaticOrder S; S.init(T, INWP, F.G, (int)blockIdx.x);
        pg8::EpiInProj E{F.ws};
        pg8::gemm_phase<pg8::EpiInProj, true>(F.lds, g, S, E);
        SEAM(2);
    }
    if (IN(3)) { p3_indexer(F); p3_pooled(F); SEAM(3); }
    if (IN(4)) {
        p4_select(F);
        __syncthreads();
        pg8::Gemm g{(const f16*)(F.ws + WS_POOLED), (const f16*)(F.ws + WS_WPOOL), 1024, 256, 256, 512}; pg8::StaticOrder S; S.init(T, 1024, F.G, (int)blockIdx.x);
        pg8::EpiPool E{(f16*)(F.ws + WS_MRAW), (F.ap->in[10])};
        pg8::gemm_phase<pg8::EpiPool, true>(F.lds, g, S, E);
        SEAM(4);
    }
    if (IN(5)) {
        const f16* Q = (const f16*)(F.ws + WS_Q); const f16* Kb = (const f16*)(F.ws + WS_K); const f16* Vb = (const f16*)(F.ws + WS_V); f16* MR = (f16*)(F.ws + WS_MRAW);
        const unsigned* mb = (const unsigned*)(F.ws + WS_MASK);
        for (int c = F.vcu; c < 256; c += F.G) {
            const int qb = 7 - (c >> 5), bh = c & 31, b = bh >> 3, h = bh & 7, gk = h >> 2;
            const size_t tok0 = (size_t)b * SEQ + qb * 256;
            att::BlockRef cur{Q + tok0 * 1024 + h * 128, Kb + (size_t)b * SEQ * 256 + gk * 128, Vb + (size_t)b * SEQ * 256 + gk * 128, MR + tok0 * DM + 1024 + h * 128, mb + tok0 * 64, qb * 256};
            att::Seam S;
            att::attn_prime(cur, (char*)lds, S);
            att::attn_block(cur, cur, (char*)lds, S);
        }
        SEAM(5);
    }
    if (IN(6)) { p6_norm_merged(F); SEAM(6); }
    if (IN(7)) {
        pg8::Gemm g{(const f16*)(F.ws + WS_MRAW), (const f16*)(F.ws + WS_WOUT), DM, DM, DM, 0}; pg8::StaticOrder S; S.init(T, DM, F.G, (int)blockIdx.x);
        pg8::EpiF32Ssq E{(float*)(F.ws + WS_MIX), DM, part};
        pg8::gemm_phase<pg8::EpiF32Ssq, false>(F.lds, g, S, E);
        SEAM(7);
    }
    if (IN(8)) { p8_rowpass(F); SEAM(8); }
    if (IN(9)) {
        pg8::Gemm g{(const f16*)(F.ws + WS_H), (const f16*)(F.ws + WS_WFF1), DM, DM, DM, 0}; pg8::StaticOrder S; S.init(T, FF, F.G, (int)blockIdx.x);
        pg8::EpiRelu2 E{(f16*)(F.ws + WS_F1), FF};
        pg8::gemm_phase<pg8::EpiRelu2, true>(F.lds, g, S, E);
        SEAM(9);
    }
    if (IN(10)) {
        pg8::Gemm g{(const f16*)(F.ws + WS_F1), (const f16*)(F.ws + WS_WFF2), FF, FF, FF, 0}; pg8::StaticOrder S; S.init(T, DM, F.G, (int)blockIdx.x);
        pg8::EpiF32Ssq E{(float*)(F.ws + WS_F2), DM, part + (size_t)T * 32};
        pg8::gemm_phase<pg8::EpiF32Ssq, false>(F.lds, g, S, E);
        SEAM(10);
    }
    if (IN(11)) { p11_final(F); }
#undef IN
#undef SEAM
}

extern "C" void kernel_launch(void* const* d_in, const int* in_sizes, int n_in, void* d_out, int out_size, void* d_ws, size_t ws_size, hipStream_t stream) {
    static int grid = 0;
    if (grid == 0) {
        if (n_in != 16 || ws_size < WS_END) { fprintf(stderr, "kernel_launch: unexpected n_in %d or ws_size %zu\n", n_in, ws_size); grid = -1; return; }
        int dev = 0, cus = 0;
        if (hipGetDevice(&dev) != hipSuccess || hipDeviceGetAttribute(&cus, hipDeviceAttributeMultiprocessorCount, dev) != hipSuccess) { grid = -1; return; }
        if (hipFuncSetAttribute((const void*)hymba_fwd, hipFuncAttributeMaxDynamicSharedMemorySize, LDS_BYTES) != hipSuccess) { fprintf(stderr, "kernel_launch: hipFuncSetAttribute failed\n"); grid = -1; return; }
        int per_cu = 0;
        if (hipOccupancyMaxActiveBlocksPerMultiprocessor(&per_cu, (const void*)hymba_fwd, NTHREADS, LDS_BYTES) != hipSuccess || per_cu < 1) { fprintf(stderr, "kernel_launch: occupancy query says %d\n", per_cu); }
        (void)hipGetLastError();
        grid = cus;
    }
    if (grid < 0) return;
    (void)hipMemsetAsync((char*)d_ws + WS_CTL, 0, CTL_ZERO_BYTES, stream);
    Args a{};
    for (int i = 0; i < 16; ++i) a.in[i] = (const float*)d_in[i];
    a.out = (float*)d_out; a.ws = (unsigned char*)d_ws;
    constexpr int NL = MK_N_LAUNCHES;
    if (NL == 1) {
        a.ph_lo = 0; a.ph_hi = NPHASE;
        void* kargs[] = {&a};
        hipError_t e = hipLaunchCooperativeKernel((const void*)hymba_fwd, dim3(grid), dim3(NTHREADS), kargs, LDS_BYTES, stream);
        if (e != hipSuccess) fprintf(stderr, "cooperative launch failed: %s\n", hipGetErrorString(e));
    } else {
        for (int li = 0; li < NPHASE; ++li) { a.ph_lo = li; a.ph_hi = li + 1; hipLaunchKernelGGL(hymba_fwd, dim3(grid), dim3(NTHREADS), LDS_BYTES, stream, a); }
    }
}
```

```cpp
#include <hip/hip_runtime.h>
#include <hip/hip_cooperative_groups.h>
#include <cstdio>
#include <cstdint>
namespace cg = cooperative_groups;

#ifndef MK_N_LAUNCHES
#define MK_N_LAUNCHES 1
#endif

#define LAS __attribute__((address_space(3)))
#define GAS __attribute__((address_space(1)))
typedef _Float16 f16;
typedef _Float16 h16x8 __attribute__((ext_vector_type(8)));
typedef _Float16 h16x2 __attribute__((ext_vector_type(2)));
typedef short s16x4 __attribute__((ext_vector_type(4)));
typedef float f32x2 __attribute__((ext_vector_type(2)));
typedef float f32x4 __attribute__((ext_vector_type(4)));
typedef float f32x16 __attribute__((ext_vector_type(16)));
typedef unsigned u32x2 __attribute__((ext_vector_type(2)));
typedef unsigned u32x4 __attribute__((ext_vector_type(4)));

constexpr int NB = 4, SEQ = 2048, T = NB * SEQ, DM = 2048, FF = 8192;
constexpr int INW = 4752, INWP = 4864;
constexpr int TOPK = 256;
constexpr float RMS_EPS = 1e-6f;
constexpr int NWAVES = 8, NTHREADS = 512;

constexpr size_t MiB = 1u << 20;
constexpr size_t WS_CTL = 0, CTL_ZERO_BYTES = 1 * MiB;
constexpr size_t CTL_MODACC = 256 * 1024;
constexpr size_t WS_WIN = 1 * MiB, WS_WOUT = 20 * MiB, WS_WFF1 = 28 * MiB, WS_WFF2 = 60 * MiB, WS_WPOOL = 92 * MiB;
constexpr size_t WS_PART = 93 * MiB;
constexpr size_t WS_IDXW = 97 * MiB;
constexpr size_t WS_MASK = 98 * MiB;
constexpr size_t WS_H = 100 * MiB;
constexpr size_t WS_F2 = 100 * MiB;
constexpr size_t WS_ZP = 164 * MiB, WS_POOLED = 180 * MiB, WS_Q = 196 * MiB, WS_K = 212 * MiB, WS_V = 216 * MiB, WS_IDXK = 220 * MiB, WS_IDXQ = 222 * MiB;
constexpr size_t WS_MRAW = 254 * MiB;
constexpr size_t WS_SCORES = 286 * MiB;
constexpr size_t WS_MIX = 286 * MiB;
constexpr size_t WS_F1 = 164 * MiB;
constexpr size_t WS_END = 350 * MiB;
constexpr int CW_TMO = 0, CW_BAR = 4096;

constexpr int RING_BYTES = 131072;
constexpr int LDS_BYTES = 147456;
constexpr int MISC_OFF = LDS_BYTES - 512;

#define LDS_WAIT() asm volatile("s_waitcnt lgkmcnt(0)" ::: "memory")
#define VM_WAIT() asm volatile("s_waitcnt vmcnt(0)" ::: "memory")
__device__ __forceinline__ unsigned pkh(float lo, float hi) { f32x2 v = {lo, hi}; h16x2 h = __builtin_convertvector(v, h16x2); return __builtin_bit_cast(unsigned, h); }
__device__ __forceinline__ int wave_sum_i(int v) {
    v += __builtin_amdgcn_update_dpp(0, v, 0xB1, 0xf, 0xf, true);
    v += __builtin_amdgcn_update_dpp(0, v, 0x4E, 0xf, 0xf, true);
    v += __builtin_amdgcn_update_dpp(0, v, 0x141, 0xf, 0xf, true);
    v += __builtin_amdgcn_update_dpp(0, v, 0x140, 0xf, 0xf, true);
    return __builtin_amdgcn_readlane(v, 0) + __builtin_amdgcn_readlane(v, 16) + __builtin_amdgcn_readlane(v, 32) + __builtin_amdgcn_readlane(v, 48);
}
__device__ __forceinline__ float wave_sum(float v) {
#pragma unroll
    for (int o = 1; o < 64; o <<= 1) v += __shfl_xor(v, o);
    return v;
}

namespace pg8 {
constexpr int BM = 256, BK = 64, HALF = 128, HTB = HALF * BK * 2, STAGE_BYTES = 8 * HTB, NXCD = 8, WGM = 8;
__host__ __device__ __forceinline__ int lds_byte(int r, int c) { const int st = (r >> 4) * 2 + (c >> 5), rr = r & 15, cc = c & 31, ob = rr * 64 + cc * 2; return st * 1024 + (ob ^ (((ob >> 9) & 1) << 5)); }
__host__ __device__ __forceinline__ void stage_rc(int b, int& R, int& C) { const int st = b / 1024, sb = b % 1024, swz = sb ^ (((sb >> 9) & 1) << 5); R = (st >> 1) * 16 + swz / 64; C = (st & 1) * 32 + (swz % 64) / 2; }
__host__ __device__ __forceinline__ int perm32(int rho) { const int n = rho >> 4, i = rho & 15; return 8 * (i >> 2) + 4 * n + (i & 3); }

struct Unit { int pm, pn; };
struct Gemm { const f16* A; const f16* Bt; int lda, ldb, K, a_pn_bytes; };

struct StaticOrder {
    int nM, nN, nwg, G, c;
    __device__ void init(int M, int N, int G_, int c_) { nM = M / BM; nN = N / BM; nwg = nM * nN; G = G_; c = c_; }
    __device__ bool next(int i, Unit& u) const {
        const long L = (long)i * G + c; if (L >= nwg) return false;
        int wgid = (int)L; { const int q = nwg / NXCD, r = nwg % NXCD, xcd = wgid % NXCD, off = wgid / NXCD; wgid = (xcd < r ? xcd * (q + 1) : r * (q + 1) + (xcd - r) * q) + off; }
        const int nig = WGM * nN, gid = wgid / nig, fm = gid * WGM, gsz = (nM - fm) < WGM ? (nM - fm) : WGM;
        u.pm = fm + ((wgid % nig) % gsz); u.pn = (wgid % nig) / gsz; return true;
    }
};

struct OneUnit { int pm, pn; __device__ bool next(int i, Unit& u) const { if (i) return false; u.pm = pm; u.pn = pn; return true; } };
template <class Epi, bool ALIGN_EPI, class Sched>
__device__ __forceinline__ void gemm_phase(LAS unsigned char* lds, const Gemm g, const Sched& S, const Epi& E) {
    const int tid = threadIdx.x, wid = __builtin_amdgcn_readfirstlane(tid >> 6), lane = tid & 63, wr = wid >> 2, wc = wid & 3, fr = lane & 15, fq = lane >> 4;
    const int K = g.K, nt = K / BK;
    unsigned voffA[2], voffB[2];
#pragma unroll
    for (int i = 0; i < 2; ++i) { int R, C; stage_rc(tid * 16 + i * 8192, R, C); const int Rb = Epi::PERM ? ((R & ~31) + perm32(R & 31)) : R;
        voffA[i] = (unsigned)(R * g.lda + C) * 2u; voffB[i] = (unsigned)(Rb * g.ldb + C) * 2u; }
    const size_t kstep = (size_t)(BK * 2);
    const size_t hstepA = (size_t)HALF * g.lda * 2, hstepB = (size_t)HALF * g.ldb * 2;
    const size_t tstepA = 2 * hstepA, tstepB = 2 * hstepB;
    const unsigned ldsw = (unsigned)wid * 1024u;
    const int aoff = lds_byte(wr * 64 + fr, fq * 8), boff = lds_byte(wc * 32 + fr, fq * 8);
#define PG8_SA(b, h) (((b) * 2 + (h)) * HTB)
#define PG8_SB(b, h) ((4 + (b) * 2 + (h)) * HTB)
#define PG8_STAGE(bufoff, gbase, voff) do { _Pragma("unroll") for (int _i = 0; _i < 2; ++_i) \
        __builtin_amdgcn_global_load_lds((const unsigned*)((const char*)(gbase) + (voff)[_i]), (LAS unsigned*)(lds + (bufoff) + ldsw + _i * 8192), 16, 0, 0); } while (0)
#define PG8_LDA(dst, b, h) do { _Pragma("unroll") for (int m = 0; m < 4; ++m) _Pragma("unroll") for (int k = 0; k < 2; ++k) dst[m][k] = *(const LAS h16x8*)(lds + PG8_SA(b, h) + aoff + m * 2048 + k * 1024); } while (0)
#define PG8_LDB(dst, b, h) do { _Pragma("unroll") for (int n = 0; n < 2; ++n) _Pragma("unroll") for (int k = 0; k < 2; ++k) dst[n][k] = *(const LAS h16x8*)(lds + PG8_SB(b, h) + boff + n * 2048 + k * 1024); } while (0)
#define PG8_MMA(ai, bj, At, Bt) do { __builtin_amdgcn_s_setprio(1); _Pragma("unroll") for (int m = 0; m < 4; ++m) _Pragma("unroll") for (int n = 0; n < 2; ++n) _Pragma("unroll") for (int k = 0; k < 2; ++k) \
        acc[ai][bj][m][n] = __builtin_amdgcn_mfma_f32_16x16x32_f16(Bt[n][k], At[m][k], acc[ai][bj][m][n], 0, 0, 0); __builtin_amdgcn_s_setprio(0); } while (0)
#define PG8_WAIT_V(n) asm volatile("s_waitcnt vmcnt(" #n ")" ::: "memory")
#define PG8_WAIT_L(n) asm volatile("s_waitcnt lgkmcnt(" #n ")" ::: "memory")
#define PG8_BAR __builtin_amdgcn_s_barrier()
#define PG8_SCHED __builtin_amdgcn_sched_barrier(0)
    Unit cur, nxt; int ui = 0;
    if (!S.next(0, cur)) return;
    f32x4 acc[2][2][4][2];
#pragma unroll
    for (int a = 0; a < 2; ++a)
#pragma unroll
        for (int b = 0; b < 2; ++b)
#pragma unroll
            for (int m = 0; m < 4; ++m)
#pragma unroll
                for (int n = 0; n < 2; ++n) acc[a][b][m][n] = (f32x4){0.f, 0.f, 0.f, 0.f};
    h16x8 At[4][2], B0[2][2], B1[2][2];
    const char* cA = (const char*)g.A + (size_t)cur.pm * tstepA + (size_t)cur.pn * g.a_pn_bytes; const char* cB = (const char*)g.Bt + (size_t)cur.pn * tstepB;
    PG8_STAGE(PG8_SB(0, 0), cB, voffB); PG8_STAGE(PG8_SB(0, 1), cB + hstepB, voffB); PG8_STAGE(PG8_SA(0, 0), cA, voffA); PG8_STAGE(PG8_SA(0, 1), cA + hstepA, voffA);
    if (wr == 1) PG8_BAR;
    PG8_WAIT_V(2); PG8_BAR;
    PG8_STAGE(PG8_SB(1, 0), cB + kstep, voffB); PG8_STAGE(PG8_SA(1, 0), cA + kstep, voffA); PG8_STAGE(PG8_SB(1, 1), cB + hstepB + kstep, voffB);
    PG8_WAIT_V(6); PG8_BAR;
    for (;;) {
        const bool has_next = S.next(ui + 1, nxt);
        const char* nA = has_next ? (const char*)g.A + (size_t)nxt.pm * tstepA + (size_t)nxt.pn * g.a_pn_bytes : cA; const char* nB = has_next ? (const char*)g.Bt + (size_t)nxt.pn * tstepB : cB;
        for (int t = 0; t < nt; t += 2) {
            const bool last = (t == nt - 2);
            const char* a1 = cA + (size_t)(t + 1) * kstep;
            const char* a2 = last ? nA : cA + (size_t)(t + 2) * kstep; const char* b2 = last ? nB : cB + (size_t)(t + 2) * kstep;
            const char* a3 = a2 + kstep; const char* b3 = b2 + kstep;
            PG8_LDB(B0, 0, 0); PG8_LDB(B1, 0, 1); PG8_SCHED; PG8_LDA(At, 0, 0); PG8_STAGE(PG8_SA(1, 1), a1 + hstepA, voffA);
            PG8_WAIT_V(8); PG8_WAIT_L(0); PG8_BAR; PG8_MMA(0, 0, At, B0); PG8_MMA(0, 1, At, B1); PG8_BAR; PG8_SCHED;
            PG8_LDA(At, 0, 1); PG8_STAGE(PG8_SB(0, 0), b2, voffB); PG8_STAGE(PG8_SB(0, 1), b2 + hstepB, voffB); PG8_STAGE(PG8_SA(0, 0), a2, voffA);
            PG8_WAIT_V(8); PG8_WAIT_L(0); PG8_BAR; PG8_MMA(1, 0, At, B0); PG8_MMA(1, 1, At, B1); PG8_BAR; PG8_SCHED;
            PG8_LDB(B0, 1, 0); PG8_LDB(B1, 1, 1); PG8_SCHED; PG8_LDA(At, 1, 0); PG8_STAGE(PG8_SA(0, 1), a2 + hstepA, voffA);
            PG8_WAIT_V(8); PG8_WAIT_L(0); PG8_BAR; PG8_MMA(0, 0, At, B0); PG8_MMA(0, 1, At, B1); PG8_BAR; PG8_SCHED;
            PG8_LDA(At, 1, 1); PG8_STAGE(PG8_SB(1, 0), b3, voffB); PG8_STAGE(PG8_SB(1, 1), b3 + hstepB, voffB); PG8_STAGE(PG8_SA(1, 0), a3, voffA);
            PG8_WAIT_V(8); PG8_WAIT_L(0); PG8_BAR; PG8_MMA(1, 0, At, B0); PG8_MMA(1, 1, At, B1); PG8_BAR; PG8_SCHED;
        }
        if constexpr (ALIGN_EPI) { if (wr == 0) PG8_BAR; }
        E(acc, cur, wr, wc, fr, fq);
        if (!has_next) break;
#pragma unroll
        for (int a = 0; a < 2; ++a)
#pragma unroll
            for (int b = 0; b < 2; ++b)
#pragma unroll
                for (int m = 0; m < 4; ++m)
#pragma unroll
                    for (int n = 0; n < 2; ++n) acc[a][b][m][n] = (f32x4){0.f, 0.f, 0.f, 0.f};
        cur = nxt; cA = nA; cB = nB; ++ui;
        if constexpr (ALIGN_EPI) { if (wr == 1) PG8_BAR; }
    }
    PG8_WAIT_V(0);
    if constexpr (!ALIGN_EPI) { if (wr == 0) PG8_BAR; }
    PG8_BAR;
#undef PG8_SA
#undef PG8_SB
#undef PG8_STAGE
#undef PG8_LDA
#undef PG8_LDB
#undef PG8_MMA
#undef PG8_WAIT_V
#undef PG8_WAIT_L
#undef PG8_BAR
#undef PG8_SCHED
}

struct EpiInProj {
    static constexpr bool PERM = true;
    unsigned char* ws;
    __device__ __forceinline__ void operator()(const f32x4 (&acc)[2][2][4][2], const Unit& u, int wr, int wc, int fr, int fq) const {
        const int row0 = u.pm * BM + wr * 64 + fr;
        const int pn = u.pn;
#pragma unroll
        for (int bj = 0; bj < 2; ++bj) {
            const int c0 = pn * BM + bj * HALF + wc * 32 + 8 * fq;
            size_t boff; int pitch, cb;
            if (pn < 4) { boff = WS_ZP; pitch = 1024; cb = 0; }
            else if (pn < 8) { boff = WS_Q; pitch = 1024; cb = 1024; }
            else if (pn == 8) { boff = WS_K; pitch = 256; cb = 2048; }
            else if (pn == 9) { boff = WS_V; pitch = 256; cb = 2304; }
            else if (pn < 18) { boff = WS_IDXQ; pitch = 2048; cb = 2560; }
            else { boff = WS_IDXK; pitch = 128; cb = 4608; }
            if (pn == 18 && bj == 1) {
                const int cw = c0 - 4736;
                if (cw >= 0 && cw < 16) {
                    float* idxw = (float*)(ws + WS_IDXW);
#pragma unroll
                    for (int ai = 0; ai < 2; ++ai)
#pragma unroll
                        for (int m = 0; m < 4; ++m) { float* p = idxw + (size_t)(row0 + ai * HALF + m * 16) * 16 + cw;
                            *(f32x4*)p = acc[ai][bj][m][0]; *(f32x4*)(p + 4) = acc[ai][bj][m][1]; }
                }
            } else {
                f16* base = (f16*)(ws + boff);
#pragma unroll
                for (int ai = 0; ai < 2; ++ai)
#pragma unroll
                    for (int m = 0; m < 4; ++m) { const f32x4 v0 = acc[ai][bj][m][0], v1 = acc[ai][bj][m][1];
                        u32x4 w; w.x = pkh(v0[0], v0[1]); w.y = pkh(v0[2], v0[3]); w.z = pkh(v1[0], v1[1]); w.w = pkh(v1[2], v1[3]);
                        *(u32x4*)(base + (size_t)(row0 + ai * HALF + m * 16) * pitch + (c0 - cb)) = w; }
            }
        }
    }
};
struct EpiPool {
    static constexpr bool PERM = true;
    f16* out; const float* pscale;
    __device__ __forceinline__ void operator()(const f32x4 (&acc)[2][2][4][2], const Unit& u, int wr, int wc, int fr, int fq) const {
        const int row0 = u.pm * BM + wr * 64 + fr;
        f32x4 sv[2][2];
#pragma unroll
        for (int bj = 0; bj < 2; ++bj)
#pragma unroll
            for (int n = 0; n < 2; ++n) sv[bj][n] = *(const f32x4*)(pscale + u.pn * BM + bj * HALF + wc * 32 + 8 * fq + 4 * n);
#pragma unroll
        for (int ai = 0; ai < 2; ++ai)
#pragma unroll
            for (int m = 0; m < 4; ++m) { const int row = row0 + ai * HALF + m * 16;
#pragma unroll
                for (int bj = 0; bj < 2; ++bj) { const f32x4 v0 = acc[ai][bj][m][0] * sv[bj][0], v1 = acc[ai][bj][m][1] * sv[bj][1];
                    u32x4 w; w.x = pkh(v0[0], v0[1]); w.y = pkh(v0[2], v0[3]); w.z = pkh(v1[0], v1[1]); w.w = pkh(v1[2], v1[3]);
                    *(u32x4*)(out + (size_t)row * DM + u.pn * BM + bj * HALF + wc * 32 + 8 * fq) = w; } }
    }
};
struct EpiF32Ssq {
    static constexpr bool PERM = false;
    float* C; int ldc; float* part;
    __device__ __forceinline__ void operator()(const f32x4 (&acc)[2][2][4][2], const Unit& u, int wr, int wc, int fr, int fq) const {
        const int row0 = u.pm * BM + wr * 64 + fr, col0 = u.pn * BM + wc * 32 + 4 * fq;
#pragma unroll
        for (int ai = 0; ai < 2; ++ai)
#pragma unroll
            for (int m = 0; m < 4; ++m) { const int row = row0 + ai * HALF + m * 16; float* rowp = C + (size_t)row * ldc + col0; float ss = 0.f;
#pragma unroll
                for (int bj = 0; bj < 2; ++bj)
#pragma unroll
                    for (int n = 0; n < 2; ++n) { const f32x4 v = acc[ai][bj][m][n]; ss += (v[0] * v[0] + v[1] * v[1]) + (v[2] * v[2] + v[3] * v[3]); *(f32x4*)(rowp + bj * HALF + n * 16) = v; }
                ss += __shfl_xor(ss, 16); ss += __shfl_xor(ss, 32);
                if (fq == 0) part[(size_t)row * 32 + u.pn * 4 + wc] = ss; }
    }
};
struct EpiRelu2 {
    static constexpr bool PERM = true;
    f16* O; int ldc;
    __device__ __forceinline__ void operator()(const f32x4 (&acc)[2][2][4][2], const Unit& u, int wr, int wc, int fr, int fq) const {
        const int row0 = u.pm * BM + wr * 64 + fr, col0 = u.pn * BM + wc * 32 + 8 * fq;
#pragma unroll
        for (int ai = 0; ai < 2; ++ai)
#pragma unroll
            for (int m = 0; m < 4; ++m) { f16* rowp = O + (size_t)(row0 + ai * HALF + m * 16) * ldc + col0;
#pragma unroll
                for (int bj = 0; bj < 2; ++bj) { f32x4 v0 = acc[ai][bj][m][0], v1 = acc[ai][bj][m][1];
#pragma unroll
                    for (int j = 0; j < 4; ++j) { const float a = fmaxf(v0[j], 0.f), b = fmaxf(v1[j], 0.f); v0[j] = a * a; v1[j] = b * b; }
                    u32x4 w; w.x = pkh(v0[0], v0[1]); w.y = pkh(v0[2], v0[3]); w.z = pkh(v1[0], v1[1]); w.w = pkh(v1[2], v1[3]);
                    *(u32x4*)(rowp + bj * HALF) = w; } }
    }
};
}

namespace att {
constexpr int NW = 8, QBLK = 32, KVBLK = 64, QB = NW * QBLK, D = 128;
constexpr int QS = 1024, KS = 256, OS = 2048;
constexpr int SHM_V = KVBLK * D * 2, SHM_K = KVBLK * D * 2;
constexpr int LDS_WSF = 2 * SHM_V + 2 * SHM_K;
constexpr int LDS_MASK = LDS_WSF + NW * 64 * 4;
constexpr int MROW = 264;
constexpr int LDS_TOTAL = LDS_MASK + NW * 32 * MROW;
constexpr float SCALE = 0.08838834764831845f;
constexpr float THR = 8.f;
#define KSWZ(row, colB) ((row) * 256 + ((colB) ^ (((row) & 7) << 4)))
#define SBAR() __builtin_amdgcn_sched_barrier(0)
__device__ __forceinline__ int v_st(int k, int c) { const int kk = (k & ~0xC) | ((k & 4) << 1) | ((k & 8) >> 1); return ((kk >> 3) * 4 + (c >> 5)) * 512 + ((kk & 7) * 32 + (c & 31)) * 2; }
__device__ __forceinline__ int v_rd_base(int lane) { return ((lane & 3) << 3) | (((lane >> 2) & 3) << 6) | (((lane >> 4) & 1) << 5) | (((lane >> 5) & 1) << 8); }
constexpr int v_rd_off(int d0, int ks, int half) { return d0 * 512 + ks * 4096 + half * 2048; }
__device__ __forceinline__ int crow(int r, int hi) { return (r & 3) + 8 * (r >> 2) + 4 * hi; }
__device__ __forceinline__ h16x8 load8(const f16* p) { return *reinterpret_cast<const h16x8*>(p); }
__device__ __forceinline__ void apply_mask(f32x16& p, unsigned w, int hi) {
    const int ws = (int)(w >> (4 * hi));
#pragma unroll
    for (int r = 0; r < 16; ++r) { const int t = __builtin_amdgcn_sbfe(ws, (r & 3) + 8 * (r >> 2), 1); p[r] = __uint_as_float(__float_as_uint(p[r]) & (unsigned)t); }
}
__device__ __forceinline__ bool partialSM(f32x16& p0, f32x16& p1, float& m_reg, float& l_reg, float* al_l, int r32, unsigned w0, int hi) {
    float mn; bool resc;
    float pmax = p0[0];
#pragma unroll
    for (int r = 1; r < 16; ++r) pmax = fmaxf(pmax, p0[r]);
#pragma unroll
    for (int r = 0; r < 16; ++r) pmax = fmaxf(pmax, p1[r]);
    { auto rr = __builtin_amdgcn_permlane32_swap(__float_as_uint(pmax), __float_as_uint(pmax), false, false);
      pmax = fmaxf(__uint_as_float(rr[0]), __uint_as_float(rr[1])); }
    constexpr float C2 = 1.4426950408889634f * SCALE;
    if (__builtin_expect(__all((pmax - m_reg) * SCALE <= THR), 1)) { mn = m_reg; resc = false; }
    else { mn = fmaxf(m_reg, pmax); const float alpha = __builtin_amdgcn_exp2f((m_reg - mn) * C2); m_reg = mn; l_reg *= alpha; if (hi == 0) al_l[r32] = alpha; resc = true; }
    const float mnL = -mn * C2;
#pragma unroll
    for (int r = 0; r < 16; ++r) p0[r] = fmaf(p0[r], C2, mnL);
#pragma unroll
    for (int r = 0; r < 16; ++r) p1[r] = fmaf(p1[r], C2, mnL);
#pragma unroll
    for (int r = 0; r < 16; ++r) p0[r] = __builtin_amdgcn_exp2f(p0[r]);
    apply_mask(p0, w0, hi);
    return resc;
}
__device__ __forceinline__ void finishSM(f32x16& p0, f32x16& p1, float& l_reg, h16x8& pa0, h16x8& pa1, h16x8& pa2, h16x8& pa3, unsigned w1, int hi) {
#pragma unroll
    for (int r = 0; r < 16; ++r) p1[r] = __builtin_amdgcn_exp2f(p1[r]);
    apply_mask(p1, w1, hi);
    float ps = 0;
#pragma unroll
    for (int r = 0; r < 16; ++r) ps += p0[r];
#pragma unroll
    for (int r = 0; r < 16; ++r) ps += p1[r];
    { auto rr = __builtin_amdgcn_permlane32_swap(__float_as_uint(ps), __float_as_uint(ps), false, false);
      ps = __uint_as_float(rr[0]) + __uint_as_float(rr[1]); }
    l_reg += ps;
#define PK4(P, B_, OUT) do { unsigned a0 = pkh(P[B_+0], P[B_+1]), a1 = pkh(P[B_+2], P[B_+3]);                          \
        unsigned b0 = pkh(P[B_+4], P[B_+5]), b1 = pkh(P[B_+6], P[B_+7]);                                             \
        auto r0 = __builtin_amdgcn_permlane32_swap(a0, b0, false, false); auto r1 = __builtin_amdgcn_permlane32_swap(a1, b1, false, false); \
        u32x4 w = {r0[0], r1[0], r0[1], r1[1]}; OUT = *reinterpret_cast<h16x8*>(&w); } while (0)
    PK4(p0, 0, pa0); PK4(p0, 8, pa1); PK4(p1, 0, pa2); PK4(p1, 8, pa3);
#undef PK4
}
template <int KB>
__device__ __forceinline__ void qkt(f32x16& p0, f32x16& p1, const char* K_lds, int r32, int hi, const h16x8* qr) {
    p0 = f32x16{}; p1 = f32x16{};
    const char* kb[4];
#pragma unroll
    for (int dd = 0; dd < 4; ++dd) kb[dd] = K_lds + KB * SHM_K + KSWZ(r32, (dd * 16 + hi * 8) * 2);
#pragma unroll
    for (int d0 = 0; d0 < 8; ++d0) { const char* a = kb[d0 & 3] + (d0 >> 2) * 128;
        h16x8 b0 = *reinterpret_cast<const h16x8*>(a);
        h16x8 b1 = *reinterpret_cast<const h16x8*>(a + 32 * 256);
        p0 = __builtin_amdgcn_mfma_f32_32x32x16_f16(b0, qr[d0], p0, 0, 0, 0);
        p1 = __builtin_amdgcn_mfma_f32_32x32x16_f16(b1, qr[d0], p1, 0, 0, 0); }
}
template <int VB>
__device__ __forceinline__ void pv_tile(f32x16* o, int vb0, h16x8 pa0, h16x8 pa1, h16x8 pa2, h16x8 pa3) {
#define TRRD(dst, off) asm volatile("ds_read_b64_tr_b16 %0, %1 offset:%2" : "=&v"(dst) : "v"(vb0), "i"(off) : "memory")
#define HV(l, h) __builtin_bit_cast(h16x8, (short __attribute__((ext_vector_type(8)))){l[0], l[1], l[2], l[3], h[0], h[1], h[2], h[3]})
#define PV_D0(d0) do { s16x4 l0, l1, l2, l3, h0, h1, h2, h3; constexpr int b_ = VB * SHM_V + v_rd_off(d0, 0, 0); \
        TRRD(l0, b_); TRRD(h0, b_ + 2048); TRRD(l1, b_ + 4096); TRRD(h1, b_ + 6144); TRRD(l2, b_ + 8192); TRRD(h2, b_ + 10240); TRRD(l3, b_ + 12288); TRRD(h3, b_ + 14336); \
        asm volatile("s_waitcnt lgkmcnt(0)" ::: "memory"); SBAR();   \
        o[d0] = __builtin_amdgcn_mfma_f32_32x32x16_f16(pa0, HV(l0, h0), o[d0], 0, 0, 0);   \
        o[d0] = __builtin_amdgcn_mfma_f32_32x32x16_f16(pa1, HV(l1, h1), o[d0], 0, 0, 0);   \
        o[d0] = __builtin_amdgcn_mfma_f32_32x32x16_f16(pa2, HV(l2, h2), o[d0], 0, 0, 0);   \
        o[d0] = __builtin_amdgcn_mfma_f32_32x32x16_f16(pa3, HV(l3, h3), o[d0], 0, 0, 0); } while (0)
    PV_D0(0); PV_D0(1); PV_D0(2); PV_D0(3);
#undef PV_D0
#undef HV
#undef TRRD
}
struct BlockRef { const f16* Q; const f16* K; const f16* V; f16* O; const unsigned* mrows; int P0; };
#define ROW(p, k0, rr) ((p) + (size_t)((k0) + (rr)) * KS + sc)
#define VMW() asm volatile("s_waitcnt vmcnt(0)" ::: "memory")
#define SLOAD(P, k0) do { st0 = load8(ROW(P, k0, sr)); st1 = load8(ROW(P, k0, 32 + sr)); } while (0)
#define SWRITE_K(bf) do { *(h16x8*)(K_lds + (bf) * SHM_K + kws) = st0; *(h16x8*)(K_lds + (bf) * SHM_K + kws + 32 * 256) = st1; } while (0)
#define SWRITE_V(bf) do { *(h16x8*)(V_lds + (bf) * SHM_V + vst0) = st0; *(h16x8*)(V_lds + (bf) * SHM_V + vst1) = st1; } while (0)
__device__ __forceinline__ void attn_block(const BlockRef& cur, char* lds) {
    const int tid = threadIdx.x, wid = __builtin_amdgcn_readfirstlane(tid >> 6), lane = tid & 63, r32 = lane & 31, hi = lane >> 5;
    const int NT = (cur.P0 + QB) / KVBLK;
    char* V_lds = lds; char* K_lds = lds + 2 * SHM_V;
    float* ws = (float*)(lds + LDS_WSF) + wid * 64; float* li_l = ws, * al_l = ws + 32;
    const int sr = tid >> 4, sc = (tid & 15) * 8, vst0 = v_st(sr, sc), vst1 = v_st(32 + sr, sc), kws = KSWZ(sr, sc * 2);
    const f16* Kh = cur.K; const f16* Vh = cur.V;
    h16x8 st0, st1; h16x8 qr[8];
#define KBASE(t) ((t) * KVBLK)
    SLOAD(Kh, 0);
#pragma unroll
    for (int d0 = 0; d0 < 8; ++d0) qr[d0] = load8(cur.Q + (size_t)(wid * QBLK + r32) * QS + d0 * 16 + hi * 8);
    { LAS unsigned* mr = (LAS unsigned*)((LAS char*)lds + LDS_MASK + wid * 32 * MROW);
      const unsigned* src = cur.mrows + (size_t)(wid * QBLK) * 64 + lane;
#pragma unroll 8
      for (int rr = 0; rr < 32; ++rr) mr[rr * (MROW / 4) + lane] = src[(size_t)rr * 64];
    }
    VMW(); SWRITE_K(0); SBAR(); SLOAD(Vh, 0);
    VMW(); SWRITE_V(0); SBAR(); SLOAD(Kh, KBASE(1));
    __syncthreads();
    const LAS unsigned* mrow = (const LAS unsigned*)((LAS char*)lds + LDS_MASK + wid * 32 * MROW + r32 * MROW);
    float m_reg = -1e30f, l_reg = 0; f32x16 o[4] = {};
    const int vb0 = (int)(uintptr_t)V_lds + v_rd_base(lane);
#define RESC(a) do { if (a) { asm volatile("s_waitcnt lgkmcnt(0)" ::: "memory");              \
                     for (int d_ = 0; d_ < 4; ++d_) for (int r = 0; r < 16; ++r) o[d_][r] *= al_l[crow(r, hi)]; } } while (0)
    f32x16 pA0, pA1, pB0, pB1; bool alA, alB; h16x8 pa0, pa1, pa2, pa3;
    SBAR(); qkt<0>(pA0, pA1, K_lds, r32, hi, qr);
    VMW(); SWRITE_K(1); SBAR(); SLOAD(Vh, KBASE(1));
    alA = partialSM(pA0, pA1, m_reg, l_reg, al_l, r32, mrow[0], hi); (void)alA;
    VMW(); SWRITE_V(1); SBAR(); SLOAD(Kh, KBASE(2));
    __syncthreads();
#define HALF_STEP(PX0, PX1, alX, PY0, PY1, t, KB, VB, SB) do {                                                               \
        SBAR(); qkt<KB>(PX0, PX1, K_lds, r32, hi, qr);                                                                        \
        finishSM(PY0, PY1, l_reg, pa0, pa1, pa2, pa3, mrow[2 * ((t) - 1) + 1], hi); SBAR();                                    \
        if ((t) + 1 < NT) { VMW(); SWRITE_K(SB); SBAR(); SLOAD(Vh, KBASE((t) + 1)); SBAR(); }                                 \
        pv_tile<VB>(o, vb0, pa0, pa1, pa2, pa3); alX = partialSM(PX0, PX1, m_reg, l_reg, al_l, r32, mrow[2 * (t)], hi);       \
        __syncthreads();                                                                                                      \
        if ((t) + 1 < NT) { VMW(); SWRITE_V(SB); SBAR(); if ((t) + 2 < NT) SLOAD(Kh, KBASE((t) + 2)); }                       \
        RESC(alX); __syncthreads(); } while (0)
    for (int t = 1; t + 1 < NT; t += 2) {
        HALF_STEP(pB0, pB1, alB, pA0, pA1, t, 1, 0, 0);
        HALF_STEP(pA0, pA1, alA, pB0, pB1, t + 1, 0, 1, 1);
    }
    SBAR(); qkt<1>(pB0, pB1, K_lds, r32, hi, qr); SBAR();
    finishSM(pA0, pA1, l_reg, pa0, pa1, pa2, pa3, mrow[2 * (NT - 2) + 1], hi); SBAR();
    pv_tile<0>(o, vb0, pa0, pa1, pa2, pa3);
    alB = partialSM(pB0, pB1, m_reg, l_reg, al_l, r32, mrow[2 * (NT - 1)], hi); RESC(alB);
    finishSM(pB0, pB1, l_reg, pa0, pa1, pa2, pa3, mrow[2 * (NT - 1) + 1], hi); SBAR(); pv_tile<1>(o, vb0, pa0, pa1, pa2, pa3);
    SBAR();
    if (hi == 0) li_l[r32] = l_reg; asm volatile("s_waitcnt lgkmcnt(0)" ::: "memory");
    float rli[16];
#pragma unroll
    for (int r = 0; r < 16; ++r) rli[r] = __builtin_amdgcn_rcpf(li_l[crow(r, hi)]);
    f16* Ow = cur.O + (size_t)(wid * QBLK) * OS;
#pragma unroll
    for (int r = 0; r < 16; ++r) { const int orow = crow(r, hi);
#pragma unroll
        for (int d0 = 0; d0 < 4; ++d0) { const float v = o[d0][r] * rli[r];
            const float vn = __shfl_xor(v, 1);
            if ((r32 & 1) == 0) *(unsigned*)(Ow + (size_t)orow * OS + d0 * 32 + r32) = pkh(v, vn); } }
    __syncthreads();
#undef RESC
#undef KBASE
#undef HALF_STEP
}
#undef ROW
#undef VMW
#undef SLOAD
#undef SWRITE_K
#undef SWRITE_V
#undef KSWZ
#undef SBAR
}

#define XB_TMO      128
#define XB_XCNT(j)  (256  + 64 * (j))
#define XB_XSUB(j)  (1280 + 64 * (j))
#define XB_XGEN(j)  (2304 + 64 * (j))
#define XB_TOP      3328
#define XB_TOPGEN   3392
#define XCD_BAR_WORDS 3456
#define XB_SPIN_CAP (1u << 20)
__device__ __forceinline__ unsigned xb_ld(unsigned* p)              { return __hip_atomic_load(p, __ATOMIC_RELAXED, __HIP_MEMORY_SCOPE_AGENT); }
__device__ __forceinline__ unsigned xb_add(unsigned* p, unsigned v) { return __hip_atomic_fetch_add(p, v, __ATOMIC_RELAXED, __HIP_MEMORY_SCOPE_AGENT); }
__device__ __forceinline__ unsigned xb_xcc_id() { return (unsigned)__builtin_amdgcn_s_getreg((3 << 11) | 20) & 0xFu; }
#define XB_SPIN(cond, bar) do { unsigned _sp = 0; while (cond) { __builtin_amdgcn_s_sleep(1); \
    if ((++_sp & 255u) == 0u) { if (xb_ld(&(bar)[XB_TMO])) break; if (_sp > XB_SPIN_CAP) { atomicAdd(&(bar)[XB_TMO], 1u); break; } } } } while (0)
struct XcdBarrier { unsigned* bar; unsigned x; volatile LAS unsigned* st; };
__device__ __forceinline__ XcdBarrier xcd_barrier_post(unsigned* bar, volatile LAS unsigned* st) {
    XcdBarrier b; b.bar = bar; b.x = xb_xcc_id(); b.st = st;
    if (threadIdx.x == 0) (void)xb_add(&bar[XB_XCNT(b.x)], 1u);
    return b;
}
__device__ __forceinline__ void xcd_barrier_complete(unsigned* bar, unsigned x, unsigned& nloc, unsigned& nx) {
    const unsigned G = gridDim.x * gridDim.y * gridDim.z;
    unsigned sum, cnt, mine, sp = 0u;
    for (;;) {
        sum = 0u; cnt = 0u; mine = 0u;
#pragma unroll
        for (unsigned j = 0; j < 16; ++j) { const unsigned c = xb_ld(&bar[XB_XCNT(j)]); sum += c; cnt += (c > 0u) ? 1u : 0u; mine = (j == x) ? c : mine; }
        if (sum == G) break;
        __builtin_amdgcn_s_sleep(1);
        if ((++sp & 255u) == 0u) { if (xb_ld(&bar[XB_TMO])) break; if (sp > XB_SPIN_CAP) { atomicAdd(&bar[XB_TMO], 1u); break; } }
    }
    nloc = mine > 0u ? mine : 1u; nx = cnt > 0u ? cnt : 1u;
}
__device__ __forceinline__ void xcd_barrier(const XcdBarrier& b) {
    asm volatile("s_waitcnt vmcnt(0)" ::: "memory");
    __syncthreads();
    if (threadIdx.x == 0) {
        unsigned* bar = b.bar;
        __builtin_amdgcn_s_waitcnt(0);
        unsigned nloc = b.st[0], nx = b.st[1];
        if (nloc == 0u) { xcd_barrier_complete(bar, b.x, nloc, nx); b.st[0] = nloc; b.st[1] = nx; }
        const unsigned old = xb_add(&bar[XB_XSUB(b.x)], 1u);
        const unsigned gen = old / nloc;
        if (old + 1u == (gen + 1u) * nloc) {
            __builtin_amdgcn_fence(__ATOMIC_RELEASE, "agent");
            asm volatile("s_waitcnt vmcnt(0)" ::: "memory");
            const unsigned og = xb_add(&bar[XB_TOP], 1u);
            const unsigned tg = og / nx;
            if (og + 1u == (tg + 1u) * nx) xb_add(&bar[XB_TOPGEN], 1u);
            else XB_SPIN(xb_ld(&bar[XB_TOPGEN]) == tg, bar);
            __builtin_amdgcn_fence(__ATOMIC_ACQUIRE, "agent");
            xb_add(&bar[XB_XGEN(b.x)], 1u);
            asm volatile("s_waitcnt vmcnt(0)" ::: "memory");
        } else {
            XB_SPIN(xb_ld(&bar[XB_XGEN(b.x)]) == gen, bar);
            __builtin_amdgcn_fence(__ATOMIC_ACQUIRE, "agent");
            asm volatile("s_waitcnt vmcnt(0)" ::: "memory");
        }
    }
    __syncthreads();
}

struct Args { const float* in[16]; float* out; unsigned char* ws; int ph_lo, ph_hi; };
#define CAS __attribute__((address_space(4)))
__device__ __forceinline__ int fresh_tid() { int t = threadIdx.x; asm volatile("" : "+v"(t)); return t; }
#define PHASE_IDS const int tid_ = fresh_tid(), lane_ = tid_ & 63, wave_ = __builtin_amdgcn_readfirstlane(tid_ >> 6); (void)lane_; (void)wave_
struct Frame {
    LAS unsigned char* lds; unsigned char* ldsg;
    int vcu, G;
    const CAS Args* ap;
    float* out; unsigned char* ws;
};
__device__ __forceinline__ float mod_at(const Frame& F, int b, int e) { return ((const float*)(F.ws + CTL_MODACC))[b * (6 * DM) + e] + (F.ap->in[3])[e]; }

__device__ __forceinline__ void transpose_item(const float* W, int K, int N, f16* WT, LAS float* scr, int item, int lane) {
    const int nblk = (N + 31) / 32, kb = item / nblk, nb = item % nblk, k0 = 64 * kb, n0 = 32 * nb;
    int col = n0 + (lane & 31); col = col < N ? col : N - 1;
    const float* src = W + (size_t)(k0 + (lane >> 5)) * N + col;
    float v[32];
#pragma unroll
    for (int i = 0; i < 32; ++i) v[i] = src[(size_t)(2 * i) * N];
#pragma unroll
    for (int i = 0; i < 32; ++i) scr[(2 * i + (lane >> 5)) * 33 + (lane & 31)] = v[i];
    LDS_WAIT(); asm volatile("" ::: "memory");
    const int c = lane & 7;
#pragma unroll
    for (int j = 0; j < 4; ++j) { const int n = (lane >> 3) + 8 * j; const LAS float* s = scr + (8 * c) * 33 + n;
        u32x4 o; o.x = pkh(s[0 * 33], s[1 * 33]); o.y = pkh(s[2 * 33], s[3 * 33]); o.z = pkh(s[4 * 33], s[5 * 33]); o.w = pkh(s[6 * 33], s[7 * 33]);
        if (n0 + n < N) *(u32x4*)(WT + (size_t)(n0 + n) * K + k0 + 8 * c) = o; }
    LDS_WAIT(); asm volatile("" ::: "memory");
}
constexpr int CACT_OFF = 8 * 8704;
__device__ __forceinline__ void ada_prep(Frame& F) {
    PHASE_IDS;
    LAS float* cact = (LAS float*)(F.lds + CACT_OFF);
    for (int i = tid_; i < NB * DM; i += NTHREADS) { const float v = (F.ap->in[1])[i]; cact[i] = v / (1.f + __expf(-v)); }
    __syncthreads();
}
#ifndef PIPE_REPS
#define PIPE_REPS 1
#endif
__device__ __forceinline__ void ada_item(Frame& F, int cb, int kc, int lane, LAS float* scr) {
    LAS float* cact = (LAS float*)(F.lds + CACT_OFF);
    float* macc = (float*)(F.ws + CTL_MODACC);
    const int col = cb * 256 + lane * 4;
    f32x4 a0 = {0, 0, 0, 0}, a1 = a0, a2 = a0, a3 = a0;
    const float* wp = (F.ap->in[2]) + (size_t)(kc * 64) * (6 * DM) + col;
#pragma unroll 1
    for (int q = 0; q < 4; ++q) {
        f32x4 wv[16];
#pragma unroll
        for (int d = 0; d < 16; ++d) wv[d] = *(const f32x4*)(wp + (size_t)(q * 16 + d) * (6 * DM));
#pragma unroll
        for (int d = 0; d < 16; ++d) { const int dd = kc * 64 + q * 16 + d;
            a0 += wv[d] * cact[dd]; a1 += wv[d] * cact[DM + dd]; a2 += wv[d] * cact[2 * DM + dd]; a3 += wv[d] * cact[3 * DM + dd]; }
    }
    a0 *= (1.f / PIPE_REPS); a1 *= (1.f / PIPE_REPS); a2 *= (1.f / PIPE_REPS); a3 *= (1.f / PIPE_REPS);
    *(LAS f32x4*)(scr + 0 * 256 + lane * 4) = a0; *(LAS f32x4*)(scr + 1 * 256 + lane * 4) = a1; *(LAS f32x4*)(scr + 2 * 256 + lane * 4) = a2; *(LAS f32x4*)(scr + 3 * 256 + lane * 4) = a3;
    LDS_WAIT(); asm volatile("" ::: "memory");
#pragma unroll
    for (int b = 0; b < 4; ++b)
#pragma unroll
        for (int j = 0; j < 4; ++j) __hip_atomic_fetch_add(macc + b * 6 * DM + cb * 256 + j * 64 + lane, scr[b * 256 + j * 64 + lane], __ATOMIC_RELAXED, __HIP_MEMORY_SCOPE_AGENT);
    LDS_WAIT(); asm volatile("" ::: "memory");
}
constexpr int I_IN = (DM / 64) * ((INW + 31) / 32), I_OUT = (DM / 64) * (DM / 32), I_1 = (DM / 64) * (FF / 32), I_2 = (FF / 64) * (DM / 32), I_P = 4 * (256 / 64) * (256 / 32);
__device__ __forceinline__ void transposes_a(Frame& F, int w0, int nw) {
    PHASE_IDS;
    LAS float* scr = (LAS float*)(F.lds + wave_ * 8704);
    for (int it = w0; it < I_IN + I_P; it += nw) {
        int r = it;
        if (r < I_IN) { transpose_item((F.ap->in[8]), DM, INW, (f16*)(F.ws + WS_WIN), scr, r, lane_); continue; } r -= I_IN;
        { const int gi = r / 32; transpose_item((F.ap->in[9]) + (size_t)gi * 65536, 256, 256, (f16*)(F.ws + WS_WPOOL) + (size_t)gi * 65536, scr, r % 32, lane_); }
    }
}
__device__ __forceinline__ void transposes_b(Frame& F, int w0, int nw) {
    PHASE_IDS;
    LAS float* scr = (LAS float*)(F.lds + wave_ * 8704);
    for (int it = w0; it < I_OUT + I_1 + I_2; it += nw) {
        int r = it;
        if (r < I_OUT) { transpose_item((F.ap->in[13]), DM, DM, (f16*)(F.ws + WS_WOUT), scr, r, lane_); continue; } r -= I_OUT;
        if (r < I_1) { transpose_item((F.ap->in[14]), DM, FF, (f16*)(F.ws + WS_WFF1), scr, r, lane_); continue; } r -= I_1;
        transpose_item((F.ap->in[15]), FF, DM, (f16*)(F.ws + WS_WFF2), scr, r, lane_);
    }
}
__device__ __forceinline__ void p1_norm1(Frame& F) {
    PHASE_IDS;
    const int gw = F.vcu * NWAVES + wave_, NGW = F.G * NWAVES;
    f16* H = (f16*)(F.ws + WS_H);
    for (int m = gw; m < T; m += NGW) {
        const int b = m >> 11; const float* xr = (F.ap->in[0]) + (size_t)m * DM + lane_ * 4;
        f32x4 v[8]; float ss = 0.f;
#pragma unroll
        for (int j = 0; j < 8; ++j) { v[j] = *(const f32x4*)(xr + 256 * j); ss += (v[j][0] * v[j][0] + v[j][1] * v[j][1]) + (v[j][2] * v[j][2] + v[j][3] * v[j][3]); }
        const float rstd = rsqrtf(wave_sum(ss) * (1.f / DM) + RMS_EPS);
#pragma unroll
        for (int j = 0; j < 8; ++j) { const int col = lane_ * 4 + 256 * j; const f32x4 g = *(const f32x4*)((F.ap->in[4]) + col); float y[4];
#pragma unroll
            for (int e = 0; e < 4; ++e) y[e] = v[j][e] * rstd * g[e] * (1.f + mod_at(F, b, DM + col + e)) + mod_at(F, b, col + e);
            u32x2 w; w.x = pkh(y[0], y[1]); w.y = pkh(y[2], y[3]); *(u32x2*)(H + (size_t)m * DM + col) = w; }
    }
}
__device__ __forceinline__ void indexer_unit(Frame& F, int b, int qt, int kt_lo, int kt_hi) {
    PHASE_IDS;
    const f16* idxq = (const f16*)(F.ws + WS_IDXQ); const f16* idxk = (const f16*)(F.ws + WS_IDXK); const float* idxw = (const float*)(F.ws + WS_IDXW);
    float* scores = (float*)(F.ws + WS_SCORES);
    const int lane = lane_, r = lane & 31, hp = lane >> 5, wid = wave_, tid = tid_;
    const int tok0 = b * SEQ + qt * 32 + wid * 4;
    constexpr float idx_scale = 0.25f * 0.08838834764831845f;
    h16x8 a[2][8]; float wq[2][16];
#pragma unroll
    for (int tile = 0; tile < 2; ++tile) {
        const int query = tok0 + 2 * tile + ((r >> 2) & 1), head = (r & 3) + 4 * (r >> 3);
        const f16* p = idxq + (size_t)query * 2048 + head * 128 + 8 * hp;
#pragma unroll
        for (int s = 0; s < 8; ++s) a[tile][s] = *(const h16x8*)(p + 16 * s);
        const float* wp = idxw + (size_t)(tok0 + 2 * tile + hp) * 16;
#pragma unroll
        for (int j = 0; j < 4; ++j) { const f32x4 w4 = *(const f32x4*)(wp + 4 * j); wq[tile][4 * j] = w4[0] * idx_scale; wq[tile][4 * j + 1] = w4[1] * idx_scale; wq[tile][4 * j + 2] = w4[2] * idx_scale; wq[tile][4 * j + 3] = w4[3] * idx_scale; }
    }
    for (int kt = kt_lo; kt < kt_hi; kt += 2) {
        const int ntile = (kt_hi - kt) < 2 ? (kt_hi - kt) : 2;
        __syncthreads();
#pragma unroll
        for (int p = 0; p < 2; ++p) { const int row = p * 32 + (tid >> 4), c = tid & 15; int key = kt * 32 + row; key = key < SEQ ? key : SEQ - 1;
            const u32x4 v = *(const u32x4*)(idxk + (size_t)(b * SEQ + key) * 128 + c * 8);
            *(LAS u32x4*)(F.lds + row * 256 + ((c ^ (row & 15)) << 4)) = v; }
        __syncthreads();
        for (int tt = 0; tt < ntile; ++tt) {
            h16x8 bf[8];
#pragma unroll
            for (int s = 0; s < 8; ++s) { const int c = 2 * s + hp; bf[s] = *(const LAS h16x8*)(F.lds + (tt * 32 + r) * 256 + ((c ^ (r & 15)) << 4)); }
#pragma unroll
            for (int tile = 0; tile < 2; ++tile) {
                f32x16 acc = {};
#pragma unroll
                for (int s = 0; s < 8; ++s) acc = __builtin_amdgcn_mfma_f32_32x32x16_f16(a[tile][s], bf[s], acc, 0, 0, 0);
                float sc = 0.f;
#pragma unroll
                for (int g = 0; g < 16; ++g) sc = fmaf(wq[tile][g], fmaxf(acc[g], 0.f), sc);
                scores[(size_t)(tok0 + 2 * tile + hp) * SEQ + (kt + tt) * 32 + r] = sc;
            }
        }
    }
}
__device__ __forceinline__ void p3_indexer(Frame& F) {
    { const int c = F.vcu;
        const int b = c >> 6, i = c & 63;
        indexer_unit(F, b, i, 0, (i + 2) / 2);
        const int j = 63 - i;
        indexer_unit(F, b, j, (j + 2) / 2, j + 1);
    }
}
template <int WIN>
__device__ __forceinline__ void pooled_tile_w(Frame& F, int pm, int g) {
    PHASE_IDS;
    const f16* zp = (const f16*)(F.ws + WS_ZP); f16* pooled = (f16*)(F.ws + WS_POOLED);
    const int ch = g * 256 + (tid_ & 31) * 8, seg = tid_ >> 5;
#pragma unroll 1
    for (int hf = 0; hf < 2; ++hf) {
        const int rb = pm * 256 + seg * 16 + hf * 8, tb = rb & (SEQ - 1);
        h16x8 v[WIN + 7];
#pragma unroll
        for (int i = 0; i < WIN + 7; ++i) { int dr = i - (WIN - 1); dr = (tb + dr) < 0 ? -tb : dr; v[i] = *(const h16x8*)(zp + (size_t)(rb + dr) * 1024 + ch); }
#pragma unroll
        for (int j = 0; j < 8; ++j) {
            const int tpos = tb + j, cnt = (tpos + 1) < WIN ? (tpos + 1) : WIN;
            float s[8] = {0, 0, 0, 0, 0, 0, 0, 0};
#pragma unroll
            for (int w = 0; w < WIN; ++w) { const float m = w < cnt ? 1.f : 0.f;
#pragma unroll
                for (int e = 0; e < 8; ++e) s[e] += m * (float)v[WIN - 1 + j - w][e]; }
            const float inv = 1.f / (float)cnt; float u[8];
#pragma unroll
            for (int e = 0; e < 8; ++e) u[e] = (float)v[WIN - 1 + j][e];
            u32x4 o; o.x = pkh(s[0] * inv - u[0], s[1] * inv - u[1]); o.y = pkh(s[2] * inv - u[2], s[3] * inv - u[3]); o.z = pkh(s[4] * inv - u[4], s[5] * inv - u[5]); o.w = pkh(s[6] * inv - u[6], s[7] * inv - u[7]);
            *(u32x4*)(pooled + (size_t)(rb + j) * 1024 + ch) = o;
        }
    }
}
__device__ __forceinline__ void pooled_tile(Frame& F, int pm, int g) {
    if (g == 0) pooled_tile_w<2>(F, pm, g); else if (g == 1) pooled_tile_w<4>(F, pm, g); else if (g == 2) pooled_tile_w<8>(F, pm, g); else pooled_tile_w<16>(F, pm, g);
}
__device__ __forceinline__ unsigned mono_key(float f) { const unsigned u = __float_as_uint(f); return (u & 0x80000000u) ? ~u : (u | 0x80000000u); }
__device__ __forceinline__ void p4_select(Frame& F) {
    PHASE_IDS;
    const float* scores = (const float*)(F.ws + WS_SCORES); unsigned* maskbits = (unsigned*)(F.ws + WS_MASK);
    const int gw = F.vcu * NWAVES + wave_, NGW = F.G * NWAVES, lane = lane_;
    for (int row = gw; row < T; row += NGW) {
        const int t = row & (SEQ - 1);
        unsigned myword;
        if (t < TOPK) {
            const int lo = 32 * lane; myword = (lo + 31 <= t) ? 0xFFFFFFFFu : (lo > t ? 0u : ((1u << (t - lo + 1)) - 1u));
        } else {
            unsigned u[32];
            const float* sr = scores + (size_t)row * SEQ + lane;
#pragma unroll
            for (int i = 0; i < 32; ++i) u[i] = __float_as_uint(sr[64 * i]);
#pragma unroll
            for (int i = 0; i < 32; ++i) { const int key = 64 * i + lane; u[i] = key <= t ? mono_key(__uint_as_float(u[i])) : 0u; }
            unsigned Tv = 0u; int cge = 0; bool exact = false;
            for (int bit = 31; bit >= 0; --bit) {
                const unsigned cand = Tv | (1u << bit); int cl = 0;
#pragma unroll
                for (int i = 0; i < 32; ++i) cl += (u[i] >= cand) ? 1 : 0;
                const int c = wave_sum_i(cl);
                if (c >= TOPK) { Tv = cand; cge = c; if (c == TOPK) { exact = true; break; } }
            }
            myword = 0u;
            if (exact || cge == TOPK) {
#pragma unroll
                for (int i = 0; i < 32; ++i) { const unsigned long long bal = __ballot(u[i] >= Tv); if ((lane >> 1) == i) myword = (lane & 1) ? (unsigned)(bal >> 32) : (unsigned)bal; if ((i & 3) == 3) __builtin_amdgcn_sched_barrier(0); }
            } else {
                int cgt = 0;
#pragma unroll
                for (int i = 0; i < 32; ++i) { cgt += __builtin_popcountll(__ballot(u[i] > Tv)); if ((i & 7) == 7) __builtin_amdgcn_sched_barrier(0); }
                int need = TOPK - cgt;
#pragma unroll
                for (int i = 0; i < 32; ++i) {
                    unsigned long long bal = __ballot(u[i] > Tv); unsigned long long eq = __ballot(u[i] == Tv);
                    while (eq != 0ull && need > 0) { const unsigned long long lowbit = eq & (~eq + 1ull); bal |= lowbit; eq ^= lowbit; --need; }
                    if ((lane >> 1) == i) myword = (lane & 1) ? (unsigned)(bal >> 32) : (unsigned)bal;
                    __builtin_amdgcn_sched_barrier(0);
                }
            }
        }
        maskbits[(size_t)row * 64 + lane] = myword;
    }
}
__device__ __forceinline__ void p6_norm_merged(Frame& F) {
    PHASE_IDS;
    const int gw = F.vcu * NWAVES + wave_, NGW = F.G * NWAVES, lane = lane_;
    f16* M = (f16*)(F.ws + WS_MRAW);
    for (int m = gw; m < T; m += NGW) {
        h16x8 v[4]; float sp = 0.f, sa = 0.f;
#pragma unroll
        for (int j = 0; j < 4; ++j) { v[j] = *(const h16x8*)(M + (size_t)m * DM + lane * 8 + 512 * j); float s = 0.f;
#pragma unroll
            for (int e = 0; e < 8; ++e) { const float f = (float)v[j][e]; s += f * f; }
            if (j < 2) sp += s; else sa += s; }
        sp = wave_sum(sp); sa = wave_sum(sa);
        const float rp = rsqrtf(sp * (1.f / 1024.f) + RMS_EPS), ra = rsqrtf(sa * (1.f / 1024.f) + RMS_EPS);
#pragma unroll
        for (int j = 0; j < 4; ++j) { const int col = lane * 8 + 512 * j; f16* p = M + (size_t)m * DM + col;
            const float rs = j < 2 ? rp : ra; const float* g = j < 2 ? (F.ap->in[11]) + col : (F.ap->in[12]) + (col - 1024);
            const f32x4 g0 = *(const f32x4*)g, g1 = *(const f32x4*)(g + 4);
            u32x4 o; o.x = pkh((float)v[j][0] * rs * g0[0], (float)v[j][1] * rs * g0[1]); o.y = pkh((float)v[j][2] * rs * g0[2], (float)v[j][3] * rs * g0[3]);
            o.z = pkh((float)v[j][4] * rs * g1[0], (float)v[j][5] * rs * g1[1]); o.w = pkh((float)v[j][6] * rs * g1[2], (float)v[j][7] * rs * g1[3]);
            *(u32x4*)p = o; }
    }
}
__device__ __forceinline__ void p8_rowpass(Frame& F) {
    PHASE_IDS;
    const int gw = F.vcu * NWAVES + wave_, NGW = F.G * NWAVES, lane = lane_;
    const float* mix = (const float*)(F.ws + WS_MIX); const float* pm = (const float*)(F.ws + WS_PART); f16* H = (f16*)(F.ws + WS_H);
    for (int m = gw; m < T; m += NGW) {
        const int b = m >> 11;
        float sm = lane < 32 ? pm[(size_t)m * 32 + lane] : 0.f; sm = wave_sum(sm);
        const float rm = rsqrtf(sm * (1.f / DM) + RMS_EPS);
        f32x4 x1[8]; float ss = 0.f;
#pragma unroll
        for (int j = 0; j < 8; ++j) { const int col = lane * 4 + 256 * j; const f32x4 xv = *(const f32x4*)((F.ap->in[0]) + (size_t)m * DM + col), mv = *(const f32x4*)(mix + (size_t)m * DM + col), g = *(const f32x4*)((F.ap->in[5]) + col);
#pragma unroll
            for (int e = 0; e < 4; ++e) { x1[j][e] = xv[e] + mod_at(F, b, 2 * DM + col + e) * (mv[e] * rm * g[e]); ss += x1[j][e] * x1[j][e]; }
            *(f32x4*)(F.out + (size_t)m * DM + col) = x1[j]; }
        const float r1 = rsqrtf(wave_sum(ss) * (1.f / DM) + RMS_EPS);
#pragma unroll
        for (int j = 0; j < 8; ++j) { const int col = lane * 4 + 256 * j; const f32x4 g = *(const f32x4*)((F.ap->in[6]) + col); float y[4];
#pragma unroll
            for (int e = 0; e < 4; ++e) y[e] = x1[j][e] * r1 * g[e] * (1.f + mod_at(F, b, 4 * DM + col + e)) + mod_at(F, b, 3 * DM + col + e);
            u32x2 w; w.x = pkh(y[0], y[1]); w.y = pkh(y[2], y[3]); *(u32x2*)(H + (size_t)m * DM + col) = w; }
    }
}
__device__ __forceinline__ void p11_final(Frame& F) {
    PHASE_IDS;
    const int gw = F.vcu * NWAVES + wave_, NGW = F.G * NWAVES, lane = lane_;
    const float* f2 = (const float*)(F.ws + WS_F2); const float* pf = (const float*)(F.ws + WS_PART) + (size_t)T * 32;
    for (int m = gw; m < T; m += NGW) {
        const int b = m >> 11;
        float sf = lane < 32 ? pf[(size_t)m * 32 + lane] : 0.f; sf = wave_sum(sf);
        const float rf = rsqrtf(sf * (1.f / DM) + RMS_EPS);
#pragma unroll
        for (int j = 0; j < 8; ++j) { const int col = lane * 4 + 256 * j; float* op = F.out + (size_t)m * DM + col;
            const f32x4 xv = *(const f32x4*)op, fv = *(const f32x4*)(f2 + (size_t)m * DM + col), g = *(const f32x4*)((F.ap->in[7]) + col); f32x4 o;
#pragma unroll
            for (int e = 0; e < 4; ++e) o[e] = xv[e] + mod_at(F, b, 5 * DM + col + e) * (fv[e] * rf * g[e]);
            *(f32x4*)op = o; }
    }
}

constexpr int NPHASE = 12;
__global__ void __launch_bounds__(NTHREADS, 2) hymba_fwd(Args args) {
    extern __shared__ __attribute__((aligned(16))) unsigned char lds[];
    Frame F;
    F.lds = (LAS unsigned char*)lds; F.ldsg = lds;
    F.G = gridDim.x; { const int bx = blockIdx.x; F.vcu = (F.G % 8 == 0) ? (bx % 8) * (F.G / 8) + bx / 8 : bx; }
    F.ap = (const CAS Args*)__builtin_amdgcn_kernarg_segment_ptr();
    F.out = args.out; F.ws = args.ws;
    volatile LAS unsigned* MISC = (volatile LAS unsigned*)(F.lds + MISC_OFF);
    if (threadIdx.x < 128) MISC[threadIdx.x] = 0u;
    __syncthreads();
    const int lo = args.ph_lo, hi = args.ph_hi;
    XcdBarrier bar; bar.bar = (unsigned*)(F.ws + WS_CTL) + CW_BAR; bar.x = 0; bar.st = nullptr;
    if (hi - lo > 1) bar = xcd_barrier_post((unsigned*)(F.ws + WS_CTL) + CW_BAR, MISC + 8);
#ifndef PHASE_MASK
#define PHASE_MASK 0xFFF
#endif
#define IN(k) (((PHASE_MASK >> (k)) & 1) && lo <= (k) && (k) < hi)
#define SEAM(k) do { if (IN(k) && IN((k) + 1)) xcd_barrier(bar); } while (0)
#ifndef REPEAT_MASK
#define REPEAT_MASK 0
#endif
#define REP(k) for (int rep_ = 0; rep_ < 1 + ((REPEAT_MASK >> (k)) & 1); ++rep_)
    float* part = (float*)(F.ws + WS_PART);
    const int wv_ = __builtin_amdgcn_readfirstlane(threadIdx.x >> 6);
#ifndef TIME_PHASE
#define TIME_PHASE -1
#endif
    unsigned long long tp0_ = 0, tp1_ = 0;
#define TSTART(k) do { if ((k) == TIME_PHASE) tp0_ = __builtin_amdgcn_s_memrealtime(); } while (0)
#define TEND(k) do { if ((k) == TIME_PHASE) tp1_ = __builtin_amdgcn_s_memrealtime(); } while (0)
    if (IN(0)) { TSTART(0);
        ada_prep(F);
        { const int gw = F.vcu * NWAVES + wv_; PHASE_IDS;
          if (gw < 512) ada_item(F, gw & 15, gw >> 4, lane_, (LAS float*)(F.lds + wave_ * 8704));
          else { REP(0) transposes_a(F, gw - 512, F.G * NWAVES - 512); } }
        SEAM(0); TEND(0); }
    if (IN(1)) { TSTART(1); REP(1) p1_norm1(F); SEAM(1); TEND(1); }
    if (IN(2)) { TSTART(2); REP(2) {
        pg8::Gemm g{(const f16*)(F.ws + WS_H), (const f16*)(F.ws + WS_WIN), DM, DM, DM, 0}; pg8::StaticOrder S; S.init(T, INWP, F.G, (int)blockIdx.x);
        pg8::EpiInProj E{F.ws};
        pg8::gemm_phase<pg8::EpiInProj, true>(F.lds, g, S, E); }
        REP(14) { if (blockIdx.x >= 96) transposes_b(F, ((int)blockIdx.x - 96) * NWAVES + wv_, 160 * NWAVES); }
        SEAM(2); TEND(2);
    }
    if (IN(3)) { TSTART(3); REP(3) { p3_indexer(F); } SEAM(3); TEND(3); }
    if (IN(4)) { TSTART(4); REP(13) { p4_select(F); } SEAM(4); TEND(4); }
    if (IN(5)) { TSTART(5);
        const f16* Q = (const f16*)(F.ws + WS_Q); const f16* Kb = (const f16*)(F.ws + WS_K); const f16* Vb = (const f16*)(F.ws + WS_V); f16* MR = (f16*)(F.ws + WS_MRAW);
        const unsigned* mb = (const unsigned*)(F.ws + WS_MASK);
        { const int c = F.vcu;
            const int qb = 7 - (c >> 5), bh = c & 31, b = bh >> 3, h = bh & 7, gk = h >> 2;
            const size_t tok0 = (size_t)b * SEQ + qb * 256;
            REP(5) {
            att::BlockRef cur{Q + tok0 * 1024 + h * 128, Kb + (size_t)b * SEQ * 256 + gk * 128, Vb + (size_t)b * SEQ * 256 + gk * 128, MR + tok0 * DM + 1024 + h * 128, mb + tok0 * 64, qb * 256};
            att::attn_block(cur, (char*)lds);
            }
        }
        __builtin_amdgcn_sched_barrier(0);
        { const int c = F.vcu;
            {
                PHASE_IDS;
                const int qb = 7 - (c >> 5), idx = c & 31;
                const int cnt = qb == 0 ? 8 : qb == 1 ? 7 : qb == 2 ? 5 : qb == 3 ? 4 : qb == 4 ? 4 : qb == 5 ? 3 : qb == 6 ? 1 : 0;
                const int pre = qb == 0 ? 0 : qb == 1 ? 8 : qb == 2 ? 15 : qb == 3 ? 20 : qb == 4 ? 24 : qb == 5 ? 28 : qb == 6 ? 31 : 32;
                if (cnt) { ada_prep(F); if (wave_ < cnt) { const int it = 32 * pre + idx * cnt + wave_; ada_item(F, 16 + (it & 31), it >> 5, lane_, (LAS float*)(F.lds + wave_ * 8704)); } }
            }
            if (c >= 128) {
                const int li = c - 128;
                REP(4) {
                __syncthreads();
                pooled_tile(F, li >> 2, li & 3);
                asm volatile("s_waitcnt vmcnt(0)" ::: "memory"); __syncthreads();
                pg8::Gemm g{(const f16*)(F.ws + WS_POOLED), (const f16*)(F.ws + WS_WPOOL), 1024, 256, 256, 512}; pg8::OneUnit S1{li >> 2, li & 3};
                pg8::EpiPool E{(f16*)(F.ws + WS_MRAW), (F.ap->in[10])};
                pg8::gemm_phase<pg8::EpiPool, false>(F.lds, g, S1, E);
                }
            }
        }
        SEAM(5); TEND(5);
    }
    if (IN(6)) { TSTART(6); p6_norm_merged(F); SEAM(6); TEND(6); }
    if (IN(7)) { TSTART(7); REP(7) {
        pg8::Gemm g{(const f16*)(F.ws + WS_MRAW), (const f16*)(F.ws + WS_WOUT), DM, DM, DM, 0}; pg8::StaticOrder S; S.init(T, DM, F.G, (int)blockIdx.x);
        pg8::EpiF32Ssq E{(float*)(F.ws + WS_MIX), DM, part};
        pg8::gemm_phase<pg8::EpiF32Ssq, false>(F.lds, g, S, E); }
        SEAM(7); TEND(7);
    }
    if (IN(8)) { TSTART(8); REP(8) p8_rowpass(F); SEAM(8); TEND(8); }
    if (IN(9)) { TSTART(9); REP(9) {
        pg8::Gemm g{(const f16*)(F.ws + WS_H), (const f16*)(F.ws + WS_WFF1), DM, DM, DM, 0}; pg8::StaticOrder S; S.init(T, FF, F.G, (int)blockIdx.x);
        pg8::EpiRelu2 E{(f16*)(F.ws + WS_F1), FF};
        pg8::gemm_phase<pg8::EpiRelu2, true>(F.lds, g, S, E); }
        SEAM(9); TEND(9);
    }
    if (IN(10)) { TSTART(10); REP(10) {
        pg8::Gemm g{(const f16*)(F.ws + WS_F1), (const f16*)(F.ws + WS_WFF2), FF, FF, FF, 0}; pg8::StaticOrder S; S.init(T, DM, F.G, (int)blockIdx.x);
        pg8::EpiF32Ssq E{(float*)(F.ws + WS_F2), DM, part + (size_t)T * 32};
        pg8::gemm_phase<pg8::EpiF32Ssq, false>(F.lds, g, S, E); }
        SEAM(10); TEND(10);
    }
    if (IN(11)) { TSTART(11); p11_final(F); TEND(11); }
    if (TIME_PHASE >= 0 && blockIdx.x == 0 && threadIdx.x == 0) {
        const unsigned long long target = __builtin_amdgcn_s_memrealtime() + (tp1_ - tp0_);
        while (__builtin_amdgcn_s_memrealtime() < target) __builtin_amdgcn_s_sleep(8);
    }
#undef IN
#undef SEAM
}

extern "C" void kernel_launch(void* const* d_in, const int* in_sizes, int n_in, void* d_out, int out_size, void* d_ws, size_t ws_size, hipStream_t stream) {
    static int grid = 0;
    if (grid == 0) {
        if (n_in != 16 || ws_size < WS_END) { fprintf(stderr, "kernel_launch: unexpected n_in %d or ws_size %zu\n", n_in, ws_size); grid = -1; return; }
        int dev = 0, cus = 0;
        if (hipGetDevice(&dev) != hipSuccess || hipDeviceGetAttribute(&cus, hipDeviceAttributeMultiprocessorCount, dev) != hipSuccess) { grid = -1; return; }
        if (hipFuncSetAttribute((const void*)hymba_fwd, hipFuncAttributeMaxDynamicSharedMemorySize, LDS_BYTES) != hipSuccess) { fprintf(stderr, "kernel_launch: hipFuncSetAttribute failed\n"); grid = -1; return; }
        int per_cu = 0;
        if (hipOccupancyMaxActiveBlocksPerMultiprocessor(&per_cu, (const void*)hymba_fwd, NTHREADS, LDS_BYTES) != hipSuccess || per_cu < 1) { fprintf(stderr, "kernel_launch: occupancy query says %d\n", per_cu); }
        (void)hipGetLastError();
        if (cus < 256) { fprintf(stderr, "kernel_launch: this kernel needs 256 CUs, device has %d\n", cus); grid = -1; return; }
        grid = 256;
    }
    if (grid < 0) return;
    (void)hipMemsetAsync((char*)d_ws + WS_CTL, 0, CTL_ZERO_BYTES, stream);
    Args a{};
    for (int i = 0; i < 16; ++i) a.in[i] = (const float*)d_in[i];
    a.out = (float*)d_out; a.ws = (unsigned char*)d_ws;
    constexpr int NL = MK_N_LAUNCHES;
    if (NL == 1) {
        a.ph_lo = 0; a.ph_hi = NPHASE;
        void* kargs[] = {&a};
        for (int rep = 0; rep < PIPE_REPS; ++rep) {
            if (rep) (void)hipMemsetAsync((char*)d_ws + WS_CTL, 0, CTL_MODACC, stream);
            hipError_t e = hipLaunchCooperativeKernel((const void*)hymba_fwd, dim3(grid), dim3(NTHREADS), kargs, LDS_BYTES, stream);
            if (e != hipSuccess) fprintf(stderr, "cooperative launch failed: %s\n", hipGetErrorString(e));
        }
    } else {
        for (int li = 0; li < NPHASE; ++li) { a.ph_lo = li; a.ph_hi = li + 1; hipLaunchKernelGGL(hymba_fwd, dim3(grid), dim3(NTHREADS), LDS_BYTES, stream, a); }
    }
}
```
